# Optimizing an MI355X kernel written in HIP

```python
import jax, jax.numpy as jnp
from jax import lax
import numpy as np

D_MODEL = 1024
BATCH = 8
SEQ = 2048
DEPTH = 1

D_MLSTM = D_MODEL
N_MLSTM_HEADS = 4
MLSTM_HEAD_DIM = D_MLSTM // N_MLSTM_HEADS
QKV_BLOCK = 4
N_QKV_BLOCKS = D_MLSTM // QKV_BLOCK
CONV_WIDTH = 4
CHUNK = 64
D_FOX = D_MODEL
N_FOX_HEADS = 8
FOX_HEAD_DIM = D_FOX // N_FOX_HEADS
Q_BLOCK = 128
D_MIX = D_MLSTM + D_FOX
IN_SPLITS = [D_MLSTM, 2 * D_MLSTM, 2 * D_MLSTM + D_FOX, 2 * D_MLSTM + 2 * D_FOX,
             2 * D_MLSTM + 3 * D_FOX, 2 * D_MLSTM + 4 * D_FOX]
D_IN_PROJ = 2 * D_MLSTM + 4 * D_FOX + N_FOX_HEADS
EPS = 1e-6

kernel_name = "hymba_mlstm_fox_hybrid"


def rms_norm(x, g):
    x32 = x.astype(jnp.float32)
    y = x32 * lax.rsqrt(jnp.mean(x32 * x32, axis=-1, keepdims=True) + EPS)
    return y.astype(x.dtype) * g


def head_rms_norm(h, g):
    B, S, H, dh = h.shape
    h32 = h.astype(jnp.float32)
    y = h32 * lax.rsqrt(jnp.mean(h32 * h32, axis=-1, keepdims=True) + EPS)
    return y.reshape(B, S, H * dh).astype(h.dtype) * g


def head_layer_norm(h, g):
    B, S, H, dh = h.shape
    h32 = h.astype(jnp.float32)
    mu = jnp.mean(h32, axis=-1, keepdims=True)
    var = jnp.mean(jnp.square(h32 - mu), axis=-1, keepdims=True)
    y = (h32 - mu) * lax.rsqrt(var + EPS)
    return y.reshape(B, S, H * dh).astype(h.dtype) * g


def causal_depthwise_conv(x, w, b):
    S = x.shape[1]
    xp = jnp.pad(x, ((0, 0), (CONV_WIDTH - 1, 0), (0, 0)))
    y = b
    for tap in range(CONV_WIDTH):
        y = y + xp[:, tap:tap + S, :] * w[tap]
    return y


def headwise_linear(x, w):
    B, S, C = x.shape
    xb = x.reshape(B, S, N_QKV_BLOCKS, QKV_BLOCK)
    return jnp.einsum('bsni,nio->bsno', xb, w).reshape(B, S, C)


def mlstm_chunkwise(q, k, v, ig, lf):
    B, H, S, dh = q.shape
    NC = S // CHUNK
    qc = q.reshape(B, H, NC, CHUNK, dh)
    kc = k.reshape(B, H, NC, CHUNK, dh)
    vc = v.reshape(B, H, NC, CHUNK, dh)
    igc = ig.reshape(B, H, NC, CHUNK)
    bcum = jnp.cumsum(lf.reshape(B, H, NC, CHUNK), axis=-1)
    gtot = bcum[..., -1]
    a = gtot[..., None] - bcum + igc

    def step(carry, xs):
        C, n, m = carry
        qj, kj, vj, aj, gj = xs
        qC = jnp.einsum('bhld,bhde->bhle', qj, C)
        qn = jnp.einsum('bhld,bhd->bhl', qj, n)
        m_new = jnp.maximum(gj + m, jnp.max(aj, axis=-1))
        decay = jnp.exp(gj + m - m_new)
        w = jnp.exp(aj - m_new[..., None])
        C = decay[..., None, None] * C + jnp.einsum('bhl,bhld,bhle->bhde', w, kj, vj)
        n = decay[..., None] * n + jnp.einsum('bhl,bhld->bhd', w, kj)
        return (C, n, m_new), (qC, qn, m)

    init = (jnp.zeros((B, H, dh, dh), jnp.float32),
            jnp.zeros((B, H, dh), jnp.float32),
            jnp.zeros((B, H), jnp.float32))
    xs = (jnp.moveaxis(qc, 2, 0), jnp.moveaxis(kc, 2, 0), jnp.moveaxis(vc, 2, 0),
          jnp.moveaxis(a, 2, 0), jnp.moveaxis(gtot, 2, 0))
    _, (qC, qn, m_prev) = lax.scan(step, init, xs)
    qC = jnp.moveaxis(qC, 0, 2)
    qn = jnp.moveaxis(qn, 0, 2)
    m_prev = jnp.moveaxis(m_prev, 0, 2)

    causal = jnp.tril(jnp.ones((CHUNK, CHUNK), dtype=bool))
    dlog = bcum[..., :, None] - bcum[..., None, :] + igc[..., None, :]
    dlog = jnp.where(causal, dlog, -jnp.inf)
    m_inter = bcum + m_prev[..., None]
    m_t = jnp.maximum(m_inter, jnp.max(dlog, axis=-1))
    w_inter = jnp.exp(m_inter - m_t)
    scores = jnp.einsum('bhcld,bhcsd->bhcls', qc, kc) * jnp.exp(dlog - m_t[..., None])
    num = w_inter[..., None] * qC + jnp.einsum('bhcls,bhcsd->bhcld', scores, vc)
    den = w_inter * qn + jnp.sum(scores, axis=-1)
    h = num / jnp.maximum(jnp.abs(den), jnp.exp(-m_t))[..., None]
    return h.reshape(B, H, S, dh)


def forgetting_attention(q, k, v, lf):
    B, H, S, dh = q.shape
    NB = S // Q_BLOCK
    scale = dh ** -0.5
    c = jnp.cumsum(lf, axis=-1)
    qb = jnp.moveaxis(q.reshape(B, H, NB, Q_BLOCK, dh), 2, 0)
    cb = jnp.moveaxis(c.reshape(B, H, NB, Q_BLOCK), 2, 0)
    starts = jnp.arange(NB, dtype=jnp.int32) * Q_BLOCK
    key_pos = jnp.arange(S, dtype=jnp.int32)

    def one_block(args):
        qi, ci, start = args
        logits = jnp.einsum('bhqd,bhkd->bhqk', qi, k).astype(jnp.float32) * scale
        logits = logits + ci[..., :, None] - c[..., None, :]
        qpos = start + jnp.arange(Q_BLOCK, dtype=jnp.int32)
        mask = key_pos[None, :] <= qpos[:, None]
        logits = jnp.where(mask, logits, -jnp.inf)
        p = jax.nn.softmax(logits, axis=-1)
        return jnp.einsum('bhqk,bhkd->bhqd', p.astype(v.dtype), v)

    out = lax.map(one_block, (qb, cb, starts))
    return jnp.moveaxis(out, 0, 2).reshape(B, H, S, dh)


def setup_inputs(seed: int = 0) -> dict:
    key = jax.random.key(seed)
    ks = jax.random.split(key, 20)
    f32 = jnp.float32
    nrm = lambda k, shape, s: jax.random.normal(k, shape, f32) * s
    return {
        "x": nrm(ks[0], (BATCH, SEQ, D_MODEL), 1.0),
        "norm_gain": 1.0 + nrm(ks[1], (DEPTH, D_MODEL), 0.02),
        "w_in": nrm(ks[2], (DEPTH, D_MODEL, D_IN_PROJ), D_MODEL ** -0.5),
        "conv_w": nrm(ks[3], (DEPTH, CONV_WIDTH, D_MLSTM), CONV_WIDTH ** -0.5),
        "conv_b": nrm(ks[4], (DEPTH, D_MLSTM), 0.02),
        "w_q_m": nrm(ks[5], (DEPTH, N_QKV_BLOCKS, QKV_BLOCK, QKV_BLOCK), QKV_BLOCK ** -0.5),
        "w_k_m": nrm(ks[6], (DEPTH, N_QKV_BLOCKS, QKV_BLOCK, QKV_BLOCK), QKV_BLOCK ** -0.5),
        "w_v_m": nrm(ks[7], (DEPTH, N_QKV_BLOCKS, QKV_BLOCK, QKV_BLOCK), QKV_BLOCK ** -0.5),
        "w_igate": nrm(ks[8], (DEPTH, 3 * D_MLSTM, N_MLSTM_HEADS), (3 * D_MLSTM) ** -0.5),
        "b_igate": nrm(ks[9], (DEPTH, N_MLSTM_HEADS), 0.1),
        "w_fgate": nrm(ks[10], (DEPTH, 3 * D_MLSTM, N_MLSTM_HEADS), (3 * D_MLSTM) ** -0.5),
        "b_fgate": jnp.tile(jnp.linspace(3.0, 6.0, N_MLSTM_HEADS, dtype=f32)[None], (DEPTH, 1))
                   + nrm(ks[11], (DEPTH, N_MLSTM_HEADS), 0.1),
        "mlstm_norm_gain": 1.0 + nrm(ks[12], (DEPTH, D_MLSTM), 0.02),
        "mlstm_skip": 1.0 + nrm(ks[13], (DEPTH, D_MLSTM), 0.02),
        "fox_forget_bias": jnp.tile(jnp.linspace(1.0, 5.0, N_FOX_HEADS, dtype=f32)[None], (DEPTH, 1))
                           + nrm(ks[14], (DEPTH, N_FOX_HEADS), 0.1),
        "fox_norm_gain": 1.0 + nrm(ks[15], (DEPTH, D_FOX), 0.02),
        "w_out": nrm(ks[16], (DEPTH, D_MIX, D_MODEL), D_MIX ** -0.5),
        "final_norm_gain": 1.0 + nrm(ks[17], (D_MODEL,), 0.02),
    }


def reference(x, norm_gain, w_in, conv_w, conv_b, w_q_m, w_k_m, w_v_m, w_igate, b_igate,
              w_fgate, b_fgate, mlstm_norm_gain, mlstm_skip, fox_forget_bias, fox_norm_gain,
              w_out, final_norm_gain):
    B, S, _ = x.shape
    for l in range(DEPTH):
        hn = rms_norm(x, norm_gain[l])
        proj = hn @ w_in[l]
        x_m, z_m, q_f, k_f, v_f, z_f, f_f = jnp.split(proj, IN_SPLITS, axis=-1)

        xc = jax.nn.silu(causal_depthwise_conv(x_m, conv_w[l], conv_b[l]))
        qm = headwise_linear(xc, w_q_m[l])
        km = headwise_linear(xc, w_k_m[l]) * (MLSTM_HEAD_DIM ** -0.5)
        vm = headwise_linear(x_m, w_v_m[l])
        qkv = jnp.concatenate([qm, km, vm], axis=-1)
        ig = (qkv @ w_igate[l] + b_igate[l]).astype(jnp.float32)
        lfm = jax.nn.log_sigmoid((qkv @ w_fgate[l] + b_fgate[l]).astype(jnp.float32))
        to_heads_m = lambda t: t.reshape(B, S, N_MLSTM_HEADS, MLSTM_HEAD_DIM).transpose(0, 2, 1, 3).astype(jnp.float32)
        hm = mlstm_chunkwise(to_heads_m(qm), to_heads_m(km), to_heads_m(vm),
                             ig.transpose(0, 2, 1), lfm.transpose(0, 2, 1))
        hm = hm.transpose(0, 2, 1, 3).astype(x.dtype)
        hm = head_layer_norm(hm, mlstm_norm_gain[l]) + mlstm_skip[l] * xc
        y_m = hm * jax.nn.silu(z_m)

        lff = jax.nn.log_sigmoid(f_f.astype(jnp.float32) + fox_forget_bias[l])
        to_heads_f = lambda t: t.reshape(B, S, N_FOX_HEADS, FOX_HEAD_DIM).transpose(0, 2, 1, 3)
        hf = forgetting_attention(to_heads_f(q_f), to_heads_f(k_f), to_heads_f(v_f),
                                  lff.transpose(0, 2, 1))
        hf = head_rms_norm(hf.transpose(0, 2, 1, 3), fox_norm_gain[l])
        y_f = hf * jax.nn.silu(z_f)

        y = jnp.concatenate([y_m, y_f], axis=-1) @ w_out[l]
        x = x + y
    return rms_norm(x, final_norm_gain)
```

```cpp
#include <hip/hip_runtime.h>
#include <hip/hip_bf16.h>
#include <cstdio>
#include <cstdint>
#include <cmath>
namespace pg8 {
#define PG8_LAS __attribute__((address_space(3)))
typedef unsigned short bf16_t;
typedef short bf16x8 __attribute__((ext_vector_type(8)));
typedef float f32x4 __attribute__((ext_vector_type(4)));
typedef unsigned u32x4 __attribute__((ext_vector_type(4)));
constexpr int BM = 256, BK = 64, HALF = 128, HTB = HALF * BK * 2  , STAGE_BYTES = 8 * HTB, NXCD = 8, WGM = 8;

__host__ __device__ __forceinline__ int lds_byte(int r, int c) { const int st = (r >> 4) * 2 + (c >> 5), rr = r & 15, cc = c & 31, ob = rr * 64 + cc * 2; return st * 1024 + (ob ^ (((ob >> 9) & 1) << 5)); }
__host__ __device__ __forceinline__ void stage_rc(int b, int& R, int& C) { const int st = b / 1024, sb = b % 1024, swz = sb ^ (((sb >> 9) & 1) << 5); R = (st >> 1) * 16 + swz / 64; C = (st & 1) * 32 + (swz % 64) / 2; }
__host__ __device__ __forceinline__ int perm32(int rho) { const int n = rho >> 4, i = rho & 15; return 8 * (i >> 2) + 4 * n + (i & 3); }

struct Unit { int pm, pn; };
struct Gemm { const bf16_t* A; const bf16_t* Bt; int M, N, K, lda, ldb; };

struct StaticOrder {
    int nM, nN, nwg, G, c;
    __host__ __device__ void init(int M, int N, int G_, int c_) { nM = M / BM; nN = N / BM; nwg = nM * nN; G = G_; c = c_; }
    __host__ __device__ bool next(int i, Unit& u) const {
        const long L = (long)i * G + c; if (L >= nwg) return false;
        int wgid = (int)L; { const int q = nwg / NXCD, r = nwg % NXCD, xcd = wgid % NXCD, off = wgid / NXCD; wgid = (xcd < r ? xcd * (q + 1) : r * (q + 1) + (xcd - r) * q) + off; }
        const int nig = WGM * nN, gid = wgid / nig, fm = gid * WGM, gsz = (nM - fm) < WGM ? (nM - fm) : WGM;
        u.pm = fm + ((wgid % nig) % gsz); u.pn = (wgid % nig) / gsz; return true;
    }
    __device__ __forceinline__ void a_ready(const Unit&) const {}
    __device__ __forceinline__ void done(const Unit&) const {}
};

__device__ __forceinline__ unsigned cvt_pk_bf16(float lo, float hi) { unsigned r; asm volatile("v_cvt_pk_bf16_f32 %0, %1, %2" : "=v"(r) : "v"(lo), "v"(hi)); return r; }
typedef float f32x2 __attribute__((ext_vector_type(2)));
__device__ __forceinline__ f32x2 gelu_pk(f32x2 v) {
    const f32x2 av = __builtin_elementwise_abs(v), d = av * 0.2316418882f + 1.0f;
    f32x2 t; t.x = __builtin_amdgcn_rcpf(d.x); t.y = __builtin_amdgcn_rcpf(d.y);
    f32x2 q = t * 0.5307027145f + (-0.7265760135f); q = q * t + 0.7107068705f; q = q * t + (-0.142248368f); q = q * t + 0.127414796f; q = q * t;
    const f32x2 s = (v * v) * (-0.72134752044f);
    f32x2 e; e.x = __builtin_amdgcn_exp2f(s.x); e.y = __builtin_amdgcn_exp2f(s.y);
    const f32x2 m = v * (q * e), r = v - m;
    f32x2 o; o.x = v.x < 0.f ? m.x : r.x; o.y = v.y < 0.f ? m.y : r.y; return o;
}

template <int ACT  > struct EpiBf16 {
    static constexpr bool PERM = true, AFTER_DRAIN = false; static_assert(ACT == 0 || ACT == 1, "EpiBf16: ACT is 0 (none) or 1 (gelu_pk)");
    bf16_t* O; int ldc; const float* bias; int split_cols; size_t split_stride; float scale0;
    __device__ __forceinline__ void operator()(const f32x4 (&acc)[2][2][4][2], const Unit& u, int wr, int wc, int fr, int fq) const {
        const int row0 = u.pm * BM + wr * 64 + fr; int colt = u.pn * BM; bf16_t* base = O;
        float sc = 1.f; if (split_cols) { const int t = colt / split_cols; base += (size_t)t * split_stride; colt -= t * split_cols; if (t == 0) sc = scale0; }
        const int col0 = colt + wc * 32 + 8 * fq, bcol0 = u.pn * BM + wc * 32 + 8 * fq;
        f32x4 bv[2][2];
#pragma unroll
        for (int bj = 0; bj < 2; ++bj)
#pragma unroll
            for (int n = 0; n < 2; ++n) bv[bj][n] = bias ? *(const f32x4*)(bias + bcol0 + bj * HALF + 4 * n) : (f32x4){0.f, 0.f, 0.f, 0.f};
#pragma unroll
        for (int ai = 0; ai < 2; ++ai)
#pragma unroll
            for (int m = 0; m < 4; ++m) { bf16_t* rowp = base + (size_t)(row0 + ai * HALF + m * 16) * ldc + col0;
#pragma unroll
                for (int bj = 0; bj < 2; ++bj) { f32x4 v0 = acc[ai][bj][m][0] + bv[bj][0], v1 = acc[ai][bj][m][1] + bv[bj][1];
                    if (ACT == 1) { f32x2 a = gelu_pk((f32x2){v0[0], v0[1]}), b = gelu_pk((f32x2){v0[2], v0[3]}), c = gelu_pk((f32x2){v1[0], v1[1]}), d = gelu_pk((f32x2){v1[2], v1[3]});
                        v0 = (f32x4){a.x, a.y, b.x, b.y}; v1 = (f32x4){c.x, c.y, d.x, d.y}; }
                    v0 = v0 * sc; v1 = v1 * sc; u32x4 w; w.x = cvt_pk_bf16(v0[0], v0[1]); w.y = cvt_pk_bf16(v0[2], v0[3]); w.z = cvt_pk_bf16(v1[0], v1[1]); w.w = cvt_pk_bf16(v1[2], v1[3]);
                    *(u32x4*)(rowp + bj * HALF) = w; } }
    }
};
struct EpiResF32 {
    static constexpr bool PERM = false, AFTER_DRAIN = false;
    const float* base; float* out; int ldc;
    __device__ __forceinline__ void operator()(const f32x4 (&acc)[2][2][4][2], const Unit& u, int wr, int wc, int fr, int fq) const {
        const int col0 = u.pn * BM + wc * 32 + 4 * fq;
#pragma unroll
        for (int ai = 0; ai < 2; ++ai)
#pragma unroll
            for (int m = 0; m < 4; ++m) { const size_t off = (size_t)(u.pm * BM + ai * HALF + wr * 64 + m * 16 + fr) * ldc + col0;
#pragma unroll
                for (int bj = 0; bj < 2; ++bj)
#pragma unroll
                    for (int n = 0; n < 2; ++n) { const f32x4 bs = *(const f32x4*)(base + off + bj * HALF + n * 16); *(f32x4*)(out + off + bj * HALF + n * 16) = bs + acc[ai][bj][m][n]; }
                if (m & 1) asm volatile("" ::: "memory"); }
    }
};
template <class Epi, class Sched, bool ALIGN_EPI = false, bool SP2 = false>
__device__ __forceinline__ void gemm_phase(PG8_LAS unsigned char* lds, const Gemm g, const Sched& S, const Epi& E) {
    const int tid = threadIdx.x, wid = __builtin_amdgcn_readfirstlane(tid >> 6), lane = tid & 63, wr = wid >> 2, wc = wid & 3, fr = lane & 15, fq = lane >> 4;
    const int K = g.K, nt = K / BK;
    unsigned voffA[2], voffB[2];
#pragma unroll
    for (int i = 0; i < 2; ++i) { int R, C; stage_rc(tid * 16 + i * 8192, R, C); const int Rb = Epi::PERM ? ((R & ~31) + perm32(R & 31)) : R;
        voffA[i] = (unsigned)(R * g.lda + C) * 2u; voffB[i] = (unsigned)(Rb * g.ldb + C) * 2u; }
    const size_t kstep = (size_t)(BK * 2);
    const size_t hstepA = (size_t)HALF * g.lda * 2, hstepB = (size_t)HALF * g.ldb * 2;
    const size_t tstepA = 2 * hstepA, tstepB = 2 * hstepB;
    const unsigned ldsw = (unsigned)wid * 1024u;
    const int aoff = lds_byte(wr * 64 + fr, fq * 8), boff = lds_byte(wc * 32 + fr, fq * 8);
#define PG8_SA(b, h) (((b) * 2 + (h)) * HTB)
#define PG8_SB(b, h) ((4 + (b) * 2 + (h)) * HTB)
#define PG8_STAGE(bufoff, gbase, voff) do { _Pragma("unroll") for (int _i = 0; _i < 2; ++_i) \
        __builtin_amdgcn_global_load_lds((const unsigned*)((const char*)(gbase) + (voff)[_i]), (PG8_LAS unsigned*)(lds + (bufoff) + ldsw + _i * 8192), 16, 0, 0); } while (0)
#define PG8_LDA(dst, b, h) do { _Pragma("unroll") for (int m = 0; m < 4; ++m) _Pragma("unroll") for (int k = 0; k < 2; ++k) dst[m][k] = *(const PG8_LAS bf16x8*)(lds + PG8_SA(b, h) + aoff + m * 2048 + k * 1024); } while (0)
#define PG8_LDB(dst, b, h) do { _Pragma("unroll") for (int n = 0; n < 2; ++n) _Pragma("unroll") for (int k = 0; k < 2; ++k) dst[n][k] = *(const PG8_LAS bf16x8*)(lds + PG8_SB(b, h) + boff + n * 2048 + k * 1024); } while (0)
#define PG8_MMA(ai, bj, At, Bt) do { __builtin_amdgcn_s_setprio(1); _Pragma("unroll") for (int m = 0; m < 4; ++m) _Pragma("unroll") for (int n = 0; n < 2; ++n) _Pragma("unroll") for (int k = 0; k < 2; ++k) \
        acc[ai][bj][m][n] = __builtin_amdgcn_mfma_f32_16x16x32_bf16(Bt[n][k], At[m][k], acc[ai][bj][m][n], 0, 0, 0); __builtin_amdgcn_s_setprio(0); } while (0)
#define PG8_WAIT_V(n) asm volatile("s_waitcnt vmcnt(" #n ")" ::: "memory")
#define PG8_WAIT_L(n) asm volatile("s_waitcnt lgkmcnt(" #n ")" ::: "memory")
#define PG8_BAR __builtin_amdgcn_s_barrier()
#define PG8_SCHED __builtin_amdgcn_sched_barrier(0)
    Unit cur, nxt; int ui = 0;
    if (!S.next(0, cur)) return;
    f32x4 acc[2][2][4][2];
#pragma unroll
    for (int a = 0; a < 2; ++a)
#pragma unroll
        for (int b = 0; b < 2; ++b)
#pragma unroll
            for (int m = 0; m < 4; ++m)
#pragma unroll
                for (int n = 0; n < 2; ++n) acc[a][b][m][n] = (f32x4){0.f, 0.f, 0.f, 0.f};
    bf16x8 At[4][2], B0[2][2], B1[2][2];
    const char* cA = (const char*)g.A + (size_t)cur.pm * tstepA; const char* cB = (const char*)g.Bt + (size_t)cur.pn * tstepB;
    S.a_ready(cur);
    if constexpr (SP2) {
        PG8_STAGE(PG8_SB(0, 0), cB, voffB); PG8_STAGE(PG8_SB(0, 1), cB + hstepB, voffB); PG8_STAGE(PG8_SA(0, 0), cA, voffA); PG8_STAGE(PG8_SA(0, 1), cA + hstepA, voffA);
        if (wr == 1) PG8_BAR;
        PG8_WAIT_V(2); PG8_BAR;
        PG8_STAGE(PG8_SB(1, 0), cB + kstep, voffB); PG8_STAGE(PG8_SA(1, 0), cA + kstep, voffA); PG8_STAGE(PG8_SB(1, 1), cB + hstepB + kstep, voffB);
        PG8_WAIT_V(6); PG8_BAR;
    } else {
        PG8_STAGE(PG8_SB(0, 0), cB, voffB); PG8_STAGE(PG8_SA(0, 0), cA, voffA); PG8_STAGE(PG8_SB(0, 1), cB + hstepB, voffB); PG8_STAGE(PG8_SA(0, 1), cA + hstepA, voffA);
        if (wr == 1) PG8_BAR;
        PG8_WAIT_V(4); PG8_BAR;
        PG8_STAGE(PG8_SB(1, 0), cB + kstep, voffB); PG8_STAGE(PG8_SA(1, 0), cA + kstep, voffA); PG8_STAGE(PG8_SB(1, 1), cB + hstepB + kstep, voffB);
        PG8_WAIT_V(6); PG8_BAR;
    }
    for (;;) {
        const bool has_next = S.next(ui + 1, nxt);
        const char* nA = has_next ? (const char*)g.A + (size_t)nxt.pm * tstepA : cA; const char* nB = has_next ? (const char*)g.Bt + (size_t)nxt.pn * tstepB : cB;
        for (int t = 0; t < nt; t += 2) {
            const bool last = (t == nt - 2);
            const char* a1 = cA + (size_t)(t + 1) * kstep;
            const char* a2 = last ? nA : cA + (size_t)(t + 2) * kstep; const char* b2 = last ? nB : cB + (size_t)(t + 2) * kstep;
            const char* a3 = a2 + kstep; const char* b3 = b2 + kstep;
            if (last && has_next) S.a_ready(nxt);
            if constexpr (SP2) {
            PG8_LDB(B0, 0, 0); PG8_LDB(B1, 0, 1); PG8_SCHED; PG8_LDA(At, 0, 0); PG8_STAGE(PG8_SA(1, 1), a1 + hstepA, voffA);
            PG8_WAIT_V(8); PG8_WAIT_L(0); PG8_BAR; PG8_MMA(0, 0, At, B0); PG8_MMA(0, 1, At, B1); PG8_BAR; PG8_SCHED;
            PG8_LDA(At, 0, 1); PG8_STAGE(PG8_SB(0, 0), b2, voffB); PG8_STAGE(PG8_SB(0, 1), b2 + hstepB, voffB); PG8_STAGE(PG8_SA(0, 0), a2, voffA);
            PG8_WAIT_V(8); PG8_WAIT_L(0); PG8_BAR; PG8_MMA(1, 0, At, B0); PG8_MMA(1, 1, At, B1); PG8_BAR; PG8_SCHED;
            PG8_LDB(B0, 1, 0); PG8_LDB(B1, 1, 1); PG8_SCHED; PG8_LDA(At, 1, 0); PG8_STAGE(PG8_SA(0, 1), a2 + hstepA, voffA);
            PG8_WAIT_V(8); PG8_WAIT_L(0); PG8_BAR; PG8_MMA(0, 0, At, B0); PG8_MMA(0, 1, At, B1); PG8_BAR; PG8_SCHED;
            PG8_LDA(At, 1, 1); PG8_STAGE(PG8_SB(1, 0), b3, voffB); PG8_STAGE(PG8_SB(1, 1), b3 + hstepB, voffB); PG8_STAGE(PG8_SA(1, 0), a3, voffA);
            PG8_WAIT_V(8); PG8_WAIT_L(0); PG8_BAR; PG8_MMA(1, 0, At, B0); PG8_MMA(1, 1, At, B1); PG8_BAR; PG8_SCHED;
            } else {
            PG8_LDB(B0, 0, 0); PG8_SCHED; PG8_LDA(At, 0, 0); PG8_STAGE(PG8_SA(1, 1), a1 + hstepA, voffA);
            PG8_WAIT_L(8); PG8_BAR; PG8_WAIT_L(0); PG8_MMA(0, 0, At, B0); PG8_BAR; PG8_SCHED;
            PG8_LDB(B1, 0, 1); PG8_STAGE(PG8_SB(0, 0), b2, voffB);
            PG8_BAR; PG8_WAIT_L(0); PG8_MMA(0, 1, At, B1); PG8_BAR;
            PG8_LDA(At, 0, 1); PG8_STAGE(PG8_SA(0, 0), a2, voffA);
            PG8_BAR; PG8_WAIT_L(0); PG8_MMA(1, 0, At, B0); PG8_BAR; PG8_SCHED;
            PG8_STAGE(PG8_SB(0, 1), b2 + hstepB, voffB);
            PG8_WAIT_V(6); PG8_BAR; PG8_MMA(1, 1, At, B1); PG8_BAR;
            PG8_LDB(B0, 1, 0); PG8_SCHED; PG8_LDA(At, 1, 0); PG8_STAGE(PG8_SA(0, 1), a2 + hstepA, voffA);
            PG8_WAIT_L(8); PG8_BAR; PG8_WAIT_L(0); PG8_MMA(0, 0, At, B0); PG8_BAR; PG8_SCHED;
            PG8_LDB(B1, 1, 1); PG8_STAGE(PG8_SB(1, 0), b3, voffB);
            PG8_BAR; PG8_WAIT_L(0); PG8_MMA(0, 1, At, B1); PG8_BAR;
            PG8_LDA(At, 1, 1); PG8_STAGE(PG8_SA(1, 0), a3, voffA);
            PG8_BAR; PG8_WAIT_L(0); PG8_MMA(1, 0, At, B0); PG8_BAR; PG8_SCHED;
            PG8_STAGE(PG8_SB(1, 1), b3 + hstepB, voffB);
            PG8_WAIT_V(6); PG8_BAR; PG8_MMA(1, 1, At, B1); PG8_BAR;
            }
        }
        if constexpr (ALIGN_EPI) { if (wr == 0) PG8_BAR; }
        if constexpr (!Epi::AFTER_DRAIN) { E(acc, cur, wr, wc, fr, fq); S.done(cur); }
        if (!has_next) break;
#pragma unroll
        for (int a = 0; a < 2; ++a)
#pragma unroll
            for (int b = 0; b < 2; ++b)
#pragma unroll
                for (int m = 0; m < 4; ++m)
#pragma unroll
                    for (int n = 0; n < 2; ++n) acc[a][b][m][n] = (f32x4){0.f, 0.f, 0.f, 0.f};
        cur = nxt; cA = nA; cB = nB; ++ui;
        if constexpr (ALIGN_EPI) { if (wr == 1) PG8_BAR; }
    }
    PG8_WAIT_V(0);
    if constexpr (!ALIGN_EPI) { if (wr == 0) PG8_BAR; }
    PG8_BAR;
    if constexpr (Epi::AFTER_DRAIN) { E.fused(acc, cur, wr, wc, fr, fq, lds, wid, lane); S.done(cur); }
#undef PG8_SA
#undef PG8_SB
#undef PG8_STAGE
#undef PG8_LDA
#undef PG8_LDB
#undef PG8_MMA
#undef PG8_WAIT_V
#undef PG8_WAIT_L
#undef PG8_BAR
#undef PG8_SCHED
}
}

#ifndef PG8_SP2
#define PG8_SP2 true
#endif
#ifndef PG8_ALIGN
#define PG8_ALIGN true
#endif
#ifndef MK_N_LAUNCHES
#define MK_N_LAUNCHES 1
#endif

constexpr int NWAVES = 8;
constexpr int BATCH = 8, SEQ = 2048, DM = 1024, T = BATCH * SEQ;
constexpr int NPROJ = 6144, NPROJ_FULL = 6152;
constexpr int COL_XM = 0, COL_ZM = 1024, COL_QF = 2048, COL_KF = 3072, COL_VF = 4096, COL_ZF = 5120;
constexpr int DMIX = 2048;
constexpr float EPS = 1e-6f;
constexpr float FOX_SCALE = 0.08838834764831845f;
constexpr float FOX_ISCALE = 11.313708498984761f;
constexpr int N_PHASES = 8;

constexpr size_t MiB = 1u << 20;
constexpr size_t WS_CTL = 0, CTL_ZERO_BYTES = 1 * MiB;
constexpr size_t WS_WIN = 1 * MiB;
constexpr size_t WS_WOUT = 13 * MiB;
constexpr size_t WS_LFF = 17 * MiB;
constexpr size_t WS_UTAB = WS_LFF + 512 * 1024;
constexpr size_t WS_GATES = 18 * MiB;
constexpr size_t WS_WGE = WS_GATES + 512 * 1024;
constexpr size_t WS_STATS = 19 * MiB;
constexpr size_t WS_XCHG = 23 * MiB;
constexpr size_t WS_HN = 24 * MiB;
constexpr size_t WS_PROJ = 56 * MiB;
constexpr size_t WS_END = 248 * MiB;
static_assert(WS_PROJ + (size_t)T * NPROJ * 2 == WS_END && WS_HN + (size_t)T * DM * 2 == WS_PROJ, "d_ws map");
constexpr int CW_TMO = 0, CW_CODE = 1;
constexpr int CW_BAR = 4096;
constexpr int CW_SEAM = 16384;
constexpr int RING_OFF = 0, RING_BYTES = 131072;
constexpr int LDSCTL_OFF = RING_BYTES, MISC_OFF = LDSCTL_OFF + 320;
constexpr int LDS_BYTES = 147456;
#define GAS __attribute__((address_space(1)))
#define LAS __attribute__((address_space(3)))
typedef unsigned short bf16;
typedef unsigned v4u __attribute__((ext_vector_type(4)));
typedef float f32x4 __attribute__((ext_vector_type(4)));
typedef short bf16x8 __attribute__((ext_vector_type(8)));
typedef GAS unsigned gu32;
typedef GAS unsigned long long gu64;
#define RLX_AGENT __ATOMIC_RELAXED, __HIP_MEMORY_SCOPE_AGENT
#define LDS_WAIT() asm volatile("s_waitcnt lgkmcnt(0)" ::: "memory")
#define VM_WAIT() asm volatile("s_waitcnt vmcnt(0)" ::: "memory")
__device__ __forceinline__ unsigned long long rt() { return __builtin_amdgcn_s_memrealtime(); }
__device__ __forceinline__ unsigned f2bf(float f) { unsigned u = __builtin_bit_cast(unsigned, f); return (u + 0x7fffu + ((u >> 16) & 1u)) >> 16; }
__device__ __forceinline__ unsigned pk2(float lo, float hi) { return f2bf(lo) | (f2bf(hi) << 16); }

#define XB_TMO      128
#define XB_XCNT(j)  (256  + 64 * (j))
#define XB_XSUB(j)  (1280 + 64 * (j))
#define XB_XGEN(j)  (2304 + 64 * (j))
#define XB_TOP      3328
#define XB_TOPGEN   3392
#define XCD_BAR_WORDS 3456
#define XB_SPIN_CAP (1u << 18)

__device__ __forceinline__ unsigned xb_ld(unsigned* p)              { return __hip_atomic_load(p, __ATOMIC_RELAXED, __HIP_MEMORY_SCOPE_AGENT); }
__device__ __forceinline__ unsigned xb_add(unsigned* p, unsigned v) { return __hip_atomic_fetch_add(p, v, __ATOMIC_RELAXED, __HIP_MEMORY_SCOPE_AGENT); }
__device__ __forceinline__ unsigned xb_xcc_id() { return (unsigned)__builtin_amdgcn_s_getreg((3 << 11) | 20) & 0xFu; }
#define XB_SPIN(cond, bar) do { unsigned _sp = 0; while (cond) { __builtin_amdgcn_s_sleep(1); \
    if ((++_sp & 255u) == 0u) { if (xb_ld(&(bar)[XB_TMO])) break; if (_sp > XB_SPIN_CAP) { atomicAdd(&(bar)[XB_TMO], 1u); break; } } } } while (0)

struct XcdBarrier {
    unsigned* bar; unsigned x;
    volatile LAS unsigned* st;
};

__device__ __forceinline__ XcdBarrier xcd_barrier_post(unsigned* bar, volatile LAS unsigned* st) {
    XcdBarrier b; b.bar = bar; b.x = xb_xcc_id(); b.st = st;
    if (threadIdx.x == 0) (void)xb_add(&bar[XB_XCNT(b.x)], 1u);
    return b;
}
__device__ __forceinline__ void xcd_barrier_complete(unsigned* bar, unsigned x, unsigned& nloc, unsigned& nx) {
    const unsigned G = gridDim.x * gridDim.y * gridDim.z;
    unsigned sum, cnt, mine, sp = 0u;
    for (;;) {
        sum = 0u; cnt = 0u; mine = 0u;
#pragma unroll
        for (unsigned j = 0; j < 16; ++j) { const unsigned c = xb_ld(&bar[XB_XCNT(j)]); sum += c; cnt += (c > 0u) ? 1u : 0u; mine = (j == x) ? c : mine; }
        if (sum == G) break;
        __builtin_amdgcn_s_sleep(1);
        if ((++sp & 255u) == 0u) { if (xb_ld(&bar[XB_TMO])) break; if (sp > XB_SPIN_CAP) { atomicAdd(&bar[XB_TMO], 1u); break; } }
    }
    nloc = mine > 0u ? mine : 1u; nx = cnt > 0u ? cnt : 1u;
}

__device__ __forceinline__ void xcd_barrier(const XcdBarrier& b) {
    asm volatile("s_waitcnt vmcnt(0)" ::: "memory");
    __syncthreads();
    if (threadIdx.x == 0) {
        unsigned* bar = b.bar;
        __builtin_amdgcn_s_waitcnt(0);
        unsigned nloc = b.st[0], nx = b.st[1];
        if (nloc == 0u) { xcd_barrier_complete(bar, b.x, nloc, nx); b.st[0] = nloc; b.st[1] = nx; }
        const unsigned old = xb_add(&bar[XB_XSUB(b.x)], 1u);
        const unsigned gen = old / nloc;
        if (old + 1u == (gen + 1u) * nloc) {
            __builtin_amdgcn_fence(__ATOMIC_RELEASE, "agent");
            asm volatile("s_waitcnt vmcnt(0)" ::: "memory");
            const unsigned og = xb_add(&bar[XB_TOP], 1u);
            const unsigned tg = og / nx;
            if (og + 1u == (tg + 1u) * nx) xb_add(&bar[XB_TOPGEN], 1u);
            else XB_SPIN(xb_ld(&bar[XB_TOPGEN]) == tg, bar);
            __builtin_amdgcn_fence(__ATOMIC_ACQUIRE, "agent");
            xb_add(&bar[XB_XGEN(b.x)], 1u);
            asm volatile("s_waitcnt vmcnt(0)" ::: "memory");
        } else {
            XB_SPIN(xb_ld(&bar[XB_XGEN(b.x)]) == gen, bar);
            __builtin_amdgcn_fence(__ATOMIC_ACQUIRE, "agent");
            asm volatile("s_waitcnt vmcnt(0)" ::: "memory");
        }
    }
    __syncthreads();
}

typedef unsigned u32x2 __attribute__((ext_vector_type(2)));
struct Ctx {
    LAS unsigned char* lds;
    int tid, lane, wave, vcu, G;
    const float* in[18];
    float* out; unsigned char* ws;
};
__device__ __forceinline__ float bf_lo(unsigned w) { return __uint_as_float(w << 16); }
__device__ __forceinline__ float bf_hi(unsigned w) { return __uint_as_float(w & 0xffff0000u); }
__device__ __forceinline__ float wave_sum(float v) {
#pragma unroll
    for (int o = 1; o < 64; o <<= 1) v += __shfl_xor(v, o);
    return v;
}
__device__ __forceinline__ float log_sigmoidf(float x) { return fminf(x, 0.f) - log1pf(expf(-fabsf(x))); }
__device__ __forceinline__ float siluf(float x) { return x / (1.f + __expf(-x)); }

__device__ __forceinline__ void p0_transpose_item(const float* W, int K, int pitch, int nblk, bf16* WT, LAS float* scr, int item, int lane) {
    const int kb = item / nblk, nb = item % nblk, k0 = 64 * kb, n0 = 32 * nb;
#pragma unroll 8
    for (int i = 0; i < 32; ++i) { const int kk = 2 * i + (lane >> 5); scr[kk * 33 + (lane & 31)] = W[(size_t)(k0 + kk) * pitch + n0 + (lane & 31)]; }
    LDS_WAIT(); asm volatile("" ::: "memory");
    const int c = lane & 7;
#pragma unroll
    for (int j = 0; j < 4; ++j) { const int n = (lane >> 3) + 8 * j; const LAS float* s = scr + (8 * c) * 33 + n;
        v4u o; o.x = pk2(s[0 * 33], s[1 * 33]); o.y = pk2(s[2 * 33], s[3 * 33]); o.z = pk2(s[4 * 33], s[5 * 33]); o.w = pk2(s[6 * 33], s[7 * 33]);
        *(GAS v4u*)(WT + (size_t)(n0 + n) * K + k0 + 8 * c) = o; }
    LDS_WAIT(); asm volatile("" ::: "memory");
}
__device__ __forceinline__ void p0_row(const Ctx& C, int m) {
    const float* x = C.in[0]; const float* ng = C.in[1]; const float* w_in = C.in[2]; const float* fbias = C.in[14];
    bf16* HN = (bf16*)(C.ws + WS_HN); float* LFF = (float*)(C.ws + WS_LFF);
    const int lane = C.lane;
    const f32x4* xr = (const f32x4*)(x + (size_t)m * DM) + lane;
    f32x4 v[4]; float s = 0.f;
#pragma unroll
    for (int j = 0; j < 4; ++j) { v[j] = xr[64 * j]; s += (v[j].x * v[j].x + v[j].y * v[j].y) + (v[j].z * v[j].z + v[j].w * v[j].w); }
    const float r = 1.0f / sqrtf(wave_sum(s) * (1.f / DM) + EPS);
    const f32x4* gr = (const f32x4*)ng + lane;
    float acc[8];
#pragma unroll
    for (int q = 0; q < 8; ++q) acc[q] = 0.f;
    unsigned long long* o8 = (unsigned long long*)(HN + (size_t)m * DM) + lane;
#pragma unroll
    for (int j = 0; j < 4; ++j) {
        const f32x4 g = gr[64 * j]; f32x4 h = (v[j] * r) * g;
        o8[64 * j] = (unsigned long long)pk2(h.x, h.y) | ((unsigned long long)pk2(h.z, h.w) << 32);
#pragma unroll
        for (int e = 0; e < 4; ++e) { const int k = 256 * j + 4 * lane + e; const float* wr = w_in + (size_t)k * NPROJ_FULL + NPROJ;
            const f32x4 wa = *(const f32x4*)wr, wb = *(const f32x4*)(wr + 4); const float he = h[e];
            acc[0] += he * wa.x; acc[1] += he * wa.y; acc[2] += he * wa.z; acc[3] += he * wa.w;
            acc[4] += he * wb.x; acc[5] += he * wb.y; acc[6] += he * wb.z; acc[7] += he * wb.w; }
    }
    float mine = 0.f;
#pragma unroll
    for (int q = 0; q < 8; ++q) { const float t = wave_sum(acc[q]); if (lane == q) mine = t; }
    if (lane < 8) LFF[(size_t)m * 8 + lane] = log_sigmoidf(mine + fbias[lane]);
}
__device__ __forceinline__ void p0_prologue(const Ctx& C) {
    LAS float* scr = (LAS float*)(C.lds + RING_OFF + C.wave * 16384);
    const int gw = C.vcu * NWAVES + C.wave, NGW = C.G * NWAVES;
    constexpr int I_IN = (DM / 64) * (NPROJ / 32), I_OUT = (DMIX / 64) * (DM / 32);
    bf16* WIN_T = (bf16*)(C.ws + WS_WIN); bf16* WOUT_T = (bf16*)(C.ws + WS_WOUT);
    for (int it = gw; it < I_IN + I_OUT; it += NGW) {
        if (it < I_IN) p0_transpose_item(C.in[2], DM, NPROJ_FULL, NPROJ / 32, WIN_T, scr, it, C.lane);
        else p0_transpose_item(C.in[16], DMIX, DM, DM / 32, WOUT_T, scr, it - I_IN, C.lane);
    }
    for (int m = gw; m < T; m += NGW) p0_row(C, m);
    {
        const float* wq = C.in[5]; const float* wk = C.in[6]; const float* wv = C.in[7]; const float* wi = C.in[8]; const float* wf = C.in[10];
        float* WGE = (float*)(C.ws + WS_WGE);
        for (int gt = C.vcu * 512 + C.tid; gt < 2048 * 8; gt += C.G * 512) {
            const int c = gt >> 3, gate = gt & 7, gh = gate & 3; const float* Wg = gate < 4 ? wi : wf;
            float s = 0.f;
            if (c < 1024) { const int n = c >> 2, i = c & 3;
#pragma unroll
                for (int o = 0; o < 4; ++o) s += wq[n * 16 + i * 4 + o] * Wg[(4 * n + o) * 4 + gh] + (wk[n * 16 + i * 4 + o] * 0.0625f) * Wg[(1024 + 4 * n + o) * 4 + gh];
            } else { const int cc = c - 1024, n = cc >> 2, i = cc & 3;
#pragma unroll
                for (int o = 0; o < 4; ++o) s += wv[n * 16 + i * 4 + o] * Wg[(2048 + 4 * n + o) * 4 + gh]; }
            WGE[gt] = s;
        }
    }
}

__device__ __forceinline__ void p2_prepass(const Ctx& C) {
    const int tid = C.tid, lane = C.lane, wave = C.wave;
    const bf16* PROJ = (const bf16*)(C.ws + WS_PROJ); bf16* XC = (bf16*)(C.ws + WS_HN);
    bf16* QM = (bf16*)C.out; bf16* KM = QM + (size_t)T * DM;
    float* GATES = (float*)(C.ws + WS_GATES); const float* WGE = (const float*)(C.ws + WS_WGE);
    LAS float* red = (LAS float*)(C.lds + RING_OFF);
    const int g = tid & 255, half = tid >> 8;
    float cw[4][4], cb[4], wq[16], wk[16], gec[4][8], gem[4][8];
#pragma unroll
    for (int tap = 0; tap < 4; ++tap) { const f32x4 w = *(const f32x4*)(C.in[3] + tap * DM + 4 * g); cw[tap][0] = w.x; cw[tap][1] = w.y; cw[tap][2] = w.z; cw[tap][3] = w.w; }
    { const f32x4 b = *(const f32x4*)(C.in[4] + 4 * g); cb[0] = b.x; cb[1] = b.y; cb[2] = b.z; cb[3] = b.w; }
#pragma unroll
    for (int i = 0; i < 4; ++i) { const f32x4 a = *(const f32x4*)(C.in[5] + g * 16 + 4 * i), b = *(const f32x4*)(C.in[6] + g * 16 + 4 * i);
        wq[4 * i] = a.x; wq[4 * i + 1] = a.y; wq[4 * i + 2] = a.z; wq[4 * i + 3] = a.w;
        wk[4 * i] = b.x * 0.0625f; wk[4 * i + 1] = b.y * 0.0625f; wk[4 * i + 2] = b.z * 0.0625f; wk[4 * i + 3] = b.w * 0.0625f; }
#pragma unroll
    for (int ch = 0; ch < 4; ++ch) {
        const f32x4 a0 = *(const f32x4*)(WGE + (size_t)(4 * g + ch) * 8), a1 = *(const f32x4*)(WGE + (size_t)(4 * g + ch) * 8 + 4);
        const f32x4 b0 = *(const f32x4*)(WGE + (size_t)(1024 + 4 * g + ch) * 8), b1 = *(const f32x4*)(WGE + (size_t)(1024 + 4 * g + ch) * 8 + 4);
        gec[ch][0] = a0.x; gec[ch][1] = a0.y; gec[ch][2] = a0.z; gec[ch][3] = a0.w; gec[ch][4] = a1.x; gec[ch][5] = a1.y; gec[ch][6] = a1.z; gec[ch][7] = a1.w;
        gem[ch][0] = b0.x; gem[ch][1] = b0.y; gem[ch][2] = b0.z; gem[ch][3] = b0.w; gem[ch][4] = b1.x; gem[ch][5] = b1.y; gem[ch][6] = b1.z; gem[ch][7] = b1.w;
    }
    for (int tile = blockIdx.x; tile < T / 64; tile += C.G) {
        const int t0 = tile * 64 + half * 32, s0 = t0 & (SEQ - 1);
        float x1[4], x2[4], x3[4];
#pragma unroll
        for (int ch = 0; ch < 4; ++ch) { x1[ch] = 0.f; x2[ch] = 0.f; x3[ch] = 0.f; }
        if (s0 >= 3) {
            const u32x2 r1 = *(const u32x2*)(PROJ + (size_t)(t0 - 1) * NPROJ + 4 * g), r2 = *(const u32x2*)(PROJ + (size_t)(t0 - 2) * NPROJ + 4 * g), r3 = *(const u32x2*)(PROJ + (size_t)(t0 - 3) * NPROJ + 4 * g);
            x1[0] = bf_lo(r1.x); x1[1] = bf_hi(r1.x); x1[2] = bf_lo(r1.y); x1[3] = bf_hi(r1.y);
            x2[0] = bf_lo(r2.x); x2[1] = bf_hi(r2.x); x2[2] = bf_lo(r2.y); x2[3] = bf_hi(r2.y);
            x3[0] = bf_lo(r3.x); x3[1] = bf_hi(r3.x); x3[2] = bf_lo(r3.y); x3[3] = bf_hi(r3.y);
        }
#pragma unroll 2
        for (int i = 0; i < 32; ++i) {
            const size_t t = (size_t)t0 + i;
            const u32x2 raw = *(const u32x2*)(PROJ + t * NPROJ + 4 * g);
            float x[4] = {bf_lo(raw.x), bf_hi(raw.x), bf_lo(raw.y), bf_hi(raw.y)};
            float xc[4];
#pragma unroll
            for (int ch = 0; ch < 4; ++ch) { float y = cb[ch]; y += x3[ch] * cw[0][ch]; y += x2[ch] * cw[1][ch]; y += x1[ch] * cw[2][ch]; y += x[ch] * cw[3][ch]; xc[ch] = siluf(y); }
            float q[4], k[4];
#pragma unroll
            for (int o = 0; o < 4; ++o) { q[o] = xc[0] * wq[o] + xc[1] * wq[4 + o] + xc[2] * wq[8 + o] + xc[3] * wq[12 + o];
                                          k[o] = xc[0] * wk[o] + xc[1] * wk[4 + o] + xc[2] * wk[8 + o] + xc[3] * wk[12 + o]; }
            float gp[8];
#pragma unroll
            for (int gt = 0; gt < 8; ++gt) { float a = 0.f;
#pragma unroll
                for (int ch = 0; ch < 4; ++ch) a += xc[ch] * gec[ch][gt] + x[ch] * gem[ch][gt];
                gp[gt] = a; }
            { u32x2 w; w.x = pk2(xc[0], xc[1]); w.y = pk2(xc[2], xc[3]); *(u32x2*)(XC + t * DM + 4 * g) = w; }
            { u32x2 w; w.x = pk2(q[0], q[1]); w.y = pk2(q[2], q[3]); *(u32x2*)(QM + t * DM + 4 * g) = w; }
            { u32x2 w; w.x = pk2(k[0], k[1]); w.y = pk2(k[2], k[3]); *(u32x2*)(KM + t * DM + 4 * g) = w; }
            float r4[4], r2[2], r1;
            const bool b5 = lane & 32, b4 = lane & 16, b3 = lane & 8;
#pragma unroll
            for (int kk = 0; kk < 4; ++kk) { const float snd = b5 ? gp[kk] : gp[kk + 4]; const float rcv = __shfl_xor(snd, 32); r4[kk] = (b5 ? gp[kk + 4] : gp[kk]) + rcv; }
#pragma unroll
            for (int kk = 0; kk < 2; ++kk) { const float snd = b4 ? r4[kk] : r4[kk + 2]; const float rcv = __shfl_xor(snd, 16); r2[kk] = (b4 ? r4[kk + 2] : r4[kk]) + rcv; }
            { const float snd = b3 ? r2[0] : r2[1]; const float rcv = __shfl_xor(snd, 8); r1 = (b3 ? r2[1] : r2[0]) + rcv; }
            r1 += __shfl_xor(r1, 4); r1 += __shfl_xor(r1, 2); r1 += __shfl_xor(r1, 1);
            if ((lane & 7) == 0) { const int gate = (b5 ? 4 : 0) + (b4 ? 2 : 0) + (b3 ? 1 : 0); red[((half * 32 + i) * 4 + (wave & 3)) * 8 + gate] = r1; }
#pragma unroll
            for (int ch = 0; ch < 4; ++ch) { x3[ch] = x2[ch]; x2[ch] = x1[ch]; x1[ch] = x[ch]; }
        }
        __syncthreads();
        { const int tok = tid >> 3, gate = tid & 7;
          float val = red[(tok * 4 + 0) * 8 + gate] + red[(tok * 4 + 1) * 8 + gate] + red[(tok * 4 + 2) * 8 + gate] + red[(tok * 4 + 3) * 8 + gate];
          val += gate < 4 ? C.in[9][gate] : C.in[11][gate - 4];
          GATES[(size_t)(tile * 64 + tok) * 8 + gate] = gate < 4 ? val : log_sigmoidf(val); }
        __syncthreads();
    }
    {
        const float* LFF = (const float*)(C.ws + WS_LFF); float* UTAB = (float*)(C.ws + WS_UTAB);
        LAS float* wsum = (LAS float*)(C.lds + RING_OFF + 16384);
        for (int bh = blockIdx.x; bh < BATCH * 8; bh += C.G) {
            const int b = bh >> 3, h = bh & 7, s = 4 * tid;
            float p[4];
#pragma unroll
            for (int j = 0; j < 4; ++j) p[j] = LFF[((size_t)b * SEQ + s + j) * 8 + h];
            p[1] += p[0]; p[2] += p[1]; p[3] += p[2];
            float incl = p[3];
#pragma unroll
            for (int o = 1; o < 64; o <<= 1) { const float tv = __shfl_up(incl, o); if (lane >= o) incl += tv; }
            if (lane == 63) wsum[wave] = incl;
            __syncthreads();
            float base = incl - p[3];
            for (int w = 0; w < wave; ++w) base += wsum[w];
#pragma unroll
            for (int j = 0; j < 4; ++j) UTAB[(size_t)bh * SEQ + s + j] = -(base + p[j]) * FOX_ISCALE;
            __syncthreads();
        }
    }
}

__device__ __forceinline__ void p3_naive_fox(const Ctx& C) {
    const int gw = C.vcu * NWAVES + C.wave, NGW = C.G * NWAVES, lane = C.lane;
    bf16* PROJ = (bf16*)(C.ws + WS_PROJ); const float* UTAB = (const float*)(C.ws + WS_UTAB); const float* gain = C.in[15];
    for (int idx = gw; idx < BATCH * 8 * SEQ; idx += NGW) {
        const int bh = idx >> 11, s = ((idx & 2047) + 331 * bh) & 2047, b = bh >> 3, h = bh & 7;
        const size_t t = (size_t)b * SEQ + s; const int col = h * 128 + 2 * lane;
        const unsigned qraw = *(const unsigned*)(PROJ + t * NPROJ + COL_QF + col);
        const float q0 = bf_lo(qraw), q1 = bf_hi(qraw);
        const float* ut = UTAB + (size_t)bh * SEQ; const float us = ut[s];
        float M = -INFINITY, l = 0.f, a0 = 0.f, a1 = 0.f;
        for (int ss = 0; ss <= s; ++ss) {
            const size_t tt = (size_t)b * SEQ + ss;
            const unsigned kraw = *(const unsigned*)(PROJ + tt * NPROJ + COL_KF + col);
            const unsigned vraw = *(const unsigned*)(PROJ + tt * NPROJ + COL_VF + col);
            float d = q0 * bf_lo(kraw) + q1 * bf_hi(kraw); d = wave_sum(d);
            const float xl = (d + (ut[ss] - us)) * FOX_SCALE;
            if (xl > M) { const float sc = __expf(M - xl); l *= sc; a0 *= sc; a1 *= sc; M = xl; }
            const float p = __expf(xl - M); l += p; a0 += p * bf_lo(vraw); a1 += p * bf_hi(vraw);
        }
        const float o0 = a0 / l, o1 = a1 / l;
        const float r = 1.0f / sqrtf(wave_sum(o0 * o0 + o1 * o1) * (1.f / 128.f) + EPS);
        const unsigned zraw = *(const unsigned*)(PROJ + t * NPROJ + COL_ZF + col);
        const float y0 = (o0 * r) * gain[col] * siluf(bf_lo(zraw)), y1 = (o1 * r) * gain[col + 1] * siluf(bf_hi(zraw));
        *(unsigned*)(PROJ + t * NPROJ + COL_QF + col) = pk2(y0, y1);
    }
}
__device__ __forceinline__ void p4_naive_mlstm(const Ctx& C, int hm_col) {
    const int gw = C.vcu * NWAVES + C.wave, NGW = C.G * NWAVES, lane = C.lane;
    bf16* PROJ = (bf16*)(C.ws + WS_PROJ); const bf16* QM = (const bf16*)C.out; const bf16* KM = QM + (size_t)T * DM;
    const float* GATES = (const float*)(C.ws + WS_GATES); float* STATS = (float*)(C.ws + WS_STATS);
    for (int idx = gw; idx < BATCH * 4 * SEQ; idx += NGW) {
        const int bh = idx >> 11, s = ((idx & 2047) + 331 * bh) & 2047, b = bh >> 2, h = bh & 3;
        const size_t t = (size_t)b * SEQ + s; const int col = h * 256 + 4 * lane;
        float wv[16];
#pragma unroll
        for (int i = 0; i < 4; ++i) { const f32x4 a = *(const f32x4*)(C.in[7] + (size_t)(h * 64 + lane) * 16 + 4 * i); wv[4 * i] = a.x; wv[4 * i + 1] = a.y; wv[4 * i + 2] = a.z; wv[4 * i + 3] = a.w; }
        const u32x2 qr = *(const u32x2*)(QM + t * DM + col);
        const float q0 = bf_lo(qr.x), q1 = bf_hi(qr.x), q2 = bf_lo(qr.y), q3 = bf_hi(qr.y);
        float D = 0.f, M = -INFINITY, den = 0.f, a0 = 0.f, a1 = 0.f, a2 = 0.f, a3 = 0.f;
        for (int ss = s; ss >= 0; --ss) {
            const size_t tt = (size_t)b * SEQ + ss;
            const u32x2 kr = *(const u32x2*)(KM + tt * DM + col);
            const u32x2 xr = *(const u32x2*)(PROJ + tt * NPROJ + COL_XM + col);
            float d = q0 * bf_lo(kr.x) + q1 * bf_hi(kr.x) + q2 * bf_lo(kr.y) + q3 * bf_hi(kr.y); d = wave_sum(d);
            const float lw = D + GATES[tt * 8 + h];
            const float x0 = bf_lo(xr.x), x1 = bf_hi(xr.x), x2 = bf_lo(xr.y), x3 = bf_hi(xr.y);
            const float v0 = x0 * wv[0] + x1 * wv[4] + x2 * wv[8] + x3 * wv[12], v1 = x0 * wv[1] + x1 * wv[5] + x2 * wv[9] + x3 * wv[13];
            const float v2 = x0 * wv[2] + x1 * wv[6] + x2 * wv[10] + x3 * wv[14], v3 = x0 * wv[3] + x1 * wv[7] + x2 * wv[11] + x3 * wv[15];
            if (lw > M) { const float sc = __expf(M - lw); den *= sc; a0 *= sc; a1 *= sc; a2 *= sc; a3 *= sc; M = lw; }
            const float wd = __expf(lw - M) * d;
            den += wd; a0 += wd * v0; a1 += wd * v1; a2 += wd * v2; a3 += wd * v3;
            D += GATES[tt * 8 + 4 + h];
        }
        const float inv = 1.0f / fmaxf(fabsf(den), __expf(-M));
        const float h0 = a0 * inv, h1 = a1 * inv, h2 = a2 * inv, h3 = a3 * inv;
        float s1 = (h0 + h1) + (h2 + h3), s2 = (h0 * h0 + h1 * h1) + (h2 * h2 + h3 * h3);
        s1 += __shfl_xor(s1, 1); s2 += __shfl_xor(s2, 1); s1 += __shfl_xor(s1, 2); s2 += __shfl_xor(s2, 2); s1 += __shfl_xor(s1, 4); s2 += __shfl_xor(s2, 4);
        if ((lane & 7) == 0) { float* st = STATS + ((t * 4 + h) * 8 + (lane >> 3)) * 2; st[0] = s1; st[1] = s2; }
        u32x2 w; w.x = pk2(h0, h1); w.y = pk2(h2, h3);
        *(u32x2*)(PROJ + t * NPROJ + hm_col + col) = w;
    }
}
__device__ __forceinline__ void p5_ym(const Ctx& C, int hm_col) {
    bf16* PROJ = (bf16*)(C.ws + WS_PROJ); const bf16* XC = (const bf16*)(C.ws + WS_HN); const float* STATS = (const float*)(C.ws + WS_STATS);
    const float* gain = C.in[12]; const float* skip = C.in[13];
    for (int tile = blockIdx.x; tile < T / 64; tile += C.G) {
#pragma unroll 2
        for (int it = 0; it < 16; ++it) {
            const int id = it * 512 + C.tid, tok = id >> 7, c0 = (id & 127) * 8, head = c0 >> 8; const size_t t = (size_t)tile * 64 + tok;
            const f32x4* st = (const f32x4*)(STATS + (t * 4 + head) * 16);
            const f32x4 sa = st[0], sb = st[1], sc = st[2], sd = st[3];
            const float sum = (sa.x + sa.z) + (sb.x + sb.z) + (sc.x + sc.z) + (sd.x + sd.z), sq = (sa.y + sa.w) + (sb.y + sb.w) + (sc.y + sc.w) + (sd.y + sd.w);
            const float mu = sum * (1.f / 256.f), var = fmaxf(sq * (1.f / 256.f) - mu * mu, 0.f), rstd = 1.0f / sqrtf(var + EPS);
            const v4u hr = *(const v4u*)(PROJ + t * NPROJ + hm_col + c0), xr = *(const v4u*)(XC + t * DM + c0), zr = *(const v4u*)(PROJ + t * NPROJ + COL_ZM + c0);
            const f32x4 g0 = *(const f32x4*)(gain + c0), g1 = *(const f32x4*)(gain + c0 + 4), k0 = *(const f32x4*)(skip + c0), k1 = *(const f32x4*)(skip + c0 + 4);
            const unsigned hw[4] = {hr.x, hr.y, hr.z, hr.w}, xw[4] = {xr.x, xr.y, xr.z, xr.w}, zw[4] = {zr.x, zr.y, zr.z, zr.w};
            const float gg[8] = {g0.x, g0.y, g0.z, g0.w, g1.x, g1.y, g1.z, g1.w}, kk[8] = {k0.x, k0.y, k0.z, k0.w, k1.x, k1.y, k1.z, k1.w};
            unsigned ow[4];
#pragma unroll
            for (int j = 0; j < 4; ++j) {
                const float ya = ((bf_lo(hw[j]) - mu) * rstd * gg[2 * j] + kk[2 * j] * bf_lo(xw[j])) * siluf(bf_lo(zw[j]));
                const float yb = ((bf_hi(hw[j]) - mu) * rstd * gg[2 * j + 1] + kk[2 * j + 1] * bf_hi(xw[j])) * siluf(bf_hi(zw[j]));
                ow[j] = pk2(ya, yb);
            }
            *(v4u*)(PROJ + t * NPROJ + COL_ZM + c0) = (v4u){ow[0], ow[1], ow[2], ow[3]};
        }
    }
}
__device__ __forceinline__ void p7_final_norm(const Ctx& C) {
    const int gw = C.vcu * NWAVES + C.wave, NGW = C.G * NWAVES, lane = C.lane; const float* fg = C.in[17];
    for (int m = gw; m < T; m += NGW) {
        f32x4* xr = (f32x4*)(C.out + (size_t)m * DM) + lane; f32x4 v[4]; float s = 0.f;
#pragma unroll
        for (int j = 0; j < 4; ++j) { v[j] = xr[64 * j]; s += (v[j].x * v[j].x + v[j].y * v[j].y) + (v[j].z * v[j].z + v[j].w * v[j].w); }
        const float r = 1.0f / sqrtf(wave_sum(s) * (1.f / DM) + EPS);
        const f32x4* gr = (const f32x4*)fg + lane;
#pragma unroll
        for (int j = 0; j < 4; ++j) xr[64 * j] = (v[j] * r) * gr[64 * j];
    }
}

struct Args { const float* in[18]; float* out; unsigned char* ws; int ph_lo, ph_hi; };
__global__ void __launch_bounds__(NWAVES * 64, 2) hy_fwd(Args args) {
    extern __shared__ __attribute__((aligned(16))) unsigned char lds[];
    Ctx C;
    C.lds = (LAS unsigned char*)lds;
    C.tid = threadIdx.x; C.lane = C.tid & 63; C.wave = __builtin_amdgcn_readfirstlane(C.tid >> 6);
    C.G = gridDim.x; { const int bx = blockIdx.x; C.vcu = (C.G % 8 == 0) ? (bx % 8) * (C.G / 8) + bx / 8 : bx; }
#pragma unroll
    for (int i = 0; i < 18; ++i) C.in[i] = args.in[i];
    C.out = args.out; C.ws = args.ws;
    volatile LAS unsigned* MISC = (volatile LAS unsigned*)(C.lds + MISC_OFF);
    gu32* ctl = (gu32*)(args.ws + WS_CTL);
    for (int u = C.tid; u < (LDS_BYTES - LDSCTL_OFF) / 4; u += NWAVES * 64) ((LAS unsigned*)(C.lds + LDSCTL_OFF))[u] = 0u;
    __syncthreads();
    const int lo = args.ph_lo, hi = args.ph_hi;
    const bool multi = (hi - lo) > 1;
    XcdBarrier bar; bar.bar = (unsigned*)(ctl + CW_BAR); bar.x = 0; bar.st = nullptr;
    if (multi) bar = xcd_barrier_post((unsigned*)(ctl + CW_BAR), MISC + 8);
#define IN(k) (lo <= (k) && (k) < hi)
#define SEAM(k) do { if (IN(k) && IN((k) + 1)) xcd_barrier(bar); } while (0)

    if (IN(0)) { p0_prologue(C); SEAM(0); }
    if (IN(1)) {
        pg8::Gemm g{(const pg8::bf16_t*)(C.ws + WS_HN), (const pg8::bf16_t*)(C.ws + WS_WIN), T, NPROJ, DM, DM, DM};
        pg8::StaticOrder S; S.init(T, NPROJ, C.G, (int)blockIdx.x);
        pg8::EpiBf16<0> E{(pg8::bf16_t*)(C.ws + WS_PROJ), NPROJ, nullptr, 0, 0, 1.f};
        pg8::gemm_phase<pg8::EpiBf16<0>, pg8::StaticOrder, PG8_ALIGN, PG8_SP2>(C.lds + RING_OFF, g, S, E);
        SEAM(1);
    }
    if (IN(2)) { p2_prepass(C); SEAM(2); }
    if (IN(3)) { p3_naive_fox(C); SEAM(3); }
    if (IN(4)) { p4_naive_mlstm(C, COL_KF); SEAM(4); }
    if (IN(5)) { p5_ym(C, COL_KF); SEAM(5); }
    if (IN(6)) {
        pg8::Gemm g{(const pg8::bf16_t*)(C.ws + WS_PROJ) + COL_ZM, (const pg8::bf16_t*)(C.ws + WS_WOUT), T, DM, DMIX, NPROJ, DMIX};
        pg8::StaticOrder S; S.init(T, DM, C.G, (int)blockIdx.x);
        pg8::EpiResF32 E{C.in[0], C.out, DM};
        pg8::gemm_phase<pg8::EpiResF32, pg8::StaticOrder, false, PG8_SP2>(C.lds + RING_OFF, g, S, E);
        SEAM(6);
    }
    if (IN(7)) { p7_final_norm(C); }
#undef IN
#undef SEAM
}

extern "C" void kernel_launch(void* const* d_in, const int* in_sizes, int n_in, void* d_out, int out_size, void* d_ws, size_t ws_size, hipStream_t stream) {
    static int grid = 0;
    if (grid == 0) {
        if (n_in != 18 || in_sizes[0] != T * DM || out_size != T * DM || ws_size < WS_END) {
            fprintf(stderr, "kernel_launch: built for 18 inputs, x/out of %d floats, >= %zu bytes of workspace; got n_in %d, in0 %d, out %d, ws %zu; nothing launched\n", T * DM, (size_t)WS_END, n_in, n_in > 0 ? in_sizes[0] : -1, out_size, ws_size);
            grid = -1; return; }
        int dev = 0, cus = 0, per_cu = 0;
        if (hipGetDevice(&dev) != hipSuccess || hipDeviceGetAttribute(&cus, hipDeviceAttributeMultiprocessorCount, dev) != hipSuccess) { fprintf(stderr, "kernel_launch: device query failed\n"); grid = -1; return; }
        if (hipFuncSetAttribute((const void*)hy_fwd, hipFuncAttributeMaxDynamicSharedMemorySize, LDS_BYTES) != hipSuccess) { fprintf(stderr, "kernel_launch: hipFuncSetAttribute failed\n"); grid = -1; return; }
        if (hipOccupancyMaxActiveBlocksPerMultiprocessor(&per_cu, (const void*)hy_fwd, NWAVES * 64, LDS_BYTES) != hipSuccess || per_cu < 1)
            fprintf(stderr, "kernel_launch: note: occupancy query reports %d workgroups per CU\n", per_cu);
        (void)hipGetLastError();
        grid = cus;
    }
    if (grid < 0) return;
    if (hipMemsetAsync((char*)d_ws + WS_CTL, 0, CTL_ZERO_BYTES, stream) != hipSuccess) { fprintf(stderr, "kernel_launch: memset failed\n"); return; }
    Args a{};
    for (int i = 0; i < 18; ++i) a.in[i] = (const float*)d_in[i];
    a.out = (float*)d_out; a.ws = (unsigned char*)d_ws;
#if MK_N_LAUNCHES == 1
    a.ph_lo = 0; a.ph_hi = N_PHASES;
    hipLaunchKernelGGL(hy_fwd, dim3(grid), dim3(NWAVES * 64), LDS_BYTES, stream, a);
#else
    for (int p = 0; p < N_PHASES; ++p) { a.ph_lo = p; a.ph_hi = p + 1; hipLaunchKernelGGL(hy_fwd, dim3(grid), dim3(NWAVES * 64), LDS_BYTES, stream, a); }
#endif
    const hipError_t le = hipPeekAtLastError();
    if (le != hipSuccess) fprintf(stderr, "kernel_launch: launch failed: %s\n", hipGetErrorName(le));
}
```

```cpp
#include <hip/hip_runtime.h>
#include <hip/hip_bf16.h>
#include <cstdio>
#include <cstdint>
#include <cmath>
namespace pg8 {
#define PG8_LAS __attribute__((address_space(3)))
typedef unsigned short bf16_t;
typedef short bf16x8 __attribute__((ext_vector_type(8)));
typedef float f32x4 __attribute__((ext_vector_type(4)));
typedef unsigned u32x4 __attribute__((ext_vector_type(4)));
constexpr int BM = 256, BK = 64, HALF = 128, HTB = HALF * BK * 2  , STAGE_BYTES = 8 * HTB, NXCD = 8, WGM = 8;

__host__ __device__ __forceinline__ int lds_byte(int r, int c) { const int st = (r >> 4) * 2 + (c >> 5), rr = r & 15, cc = c & 31, ob = rr * 64 + cc * 2; return st * 1024 + (ob ^ (((ob >> 9) & 1) << 5)); }
__host__ __device__ __forceinline__ void stage_rc(int b, int& R, int& C) { const int st = b / 1024, sb = b % 1024, swz = sb ^ (((sb >> 9) & 1) << 5); R = (st >> 1) * 16 + swz / 64; C = (st & 1) * 32 + (swz % 64) / 2; }
__host__ __device__ __forceinline__ int perm32(int rho) { const int n = rho >> 4, i = rho & 15; return 8 * (i >> 2) + 4 * n + (i & 3); }

struct Unit { int pm, pn; };
struct Gemm { const bf16_t* A; const bf16_t* Bt; int M, N, K, lda, ldb; };

struct StaticOrder {
    int nM, nN, nwg, G, c;
    __host__ __device__ void init(int M, int N, int G_, int c_) { nM = M / BM; nN = N / BM; nwg = nM * nN; G = G_; c = c_; }
    __host__ __device__ bool next(int i, Unit& u) const {
        const long L = (long)i * G + c; if (L >= nwg) return false;
        int wgid = (int)L; { const int q = nwg / NXCD, r = nwg % NXCD, xcd = wgid % NXCD, off = wgid / NXCD; wgid = (xcd < r ? xcd * (q + 1) : r * (q + 1) + (xcd - r) * q) + off; }
        const int nig = WGM * nN, gid = wgid / nig, fm = gid * WGM, gsz = (nM - fm) < WGM ? (nM - fm) : WGM;
        u.pm = fm + ((wgid % nig) % gsz); u.pn = (wgid % nig) / gsz; return true;
    }
    __device__ __forceinline__ void a_ready(const Unit&) const {}
    __device__ __forceinline__ void done(const Unit&) const {}
};

__device__ __forceinline__ unsigned cvt_pk_bf16(float lo, float hi) { unsigned r; asm volatile("v_cvt_pk_bf16_f32 %0, %1, %2" : "=v"(r) : "v"(lo), "v"(hi)); return r; }
typedef float f32x2 __attribute__((ext_vector_type(2)));
__device__ __forceinline__ f32x2 gelu_pk(f32x2 v) {
    const f32x2 av = __builtin_elementwise_abs(v), d = av * 0.2316418882f + 1.0f;
    f32x2 t; t.x = __builtin_amdgcn_rcpf(d.x); t.y = __builtin_amdgcn_rcpf(d.y);
    f32x2 q = t * 0.5307027145f + (-0.7265760135f); q = q * t + 0.7107068705f; q = q * t + (-0.142248368f); q = q * t + 0.127414796f; q = q * t;
    const f32x2 s = (v * v) * (-0.72134752044f);
    f32x2 e; e.x = __builtin_amdgcn_exp2f(s.x); e.y = __builtin_amdgcn_exp2f(s.y);
    const f32x2 m = v * (q * e), r = v - m;
    f32x2 o; o.x = v.x < 0.f ? m.x : r.x; o.y = v.y < 0.f ? m.y : r.y; return o;
}

template <int ACT  > struct EpiBf16 {
    static constexpr bool PERM = true, AFTER_DRAIN = false; static_assert(ACT == 0 || ACT == 1, "EpiBf16: ACT is 0 (none) or 1 (gelu_pk)");
    bf16_t* O; int ldc; const float* bias; int split_cols; size_t split_stride; float scale0;
    __device__ __forceinline__ void operator()(const f32x4 (&acc)[2][2][4][2], const Unit& u, int wr, int wc, int fr, int fq) const {
        const int row0 = u.pm * BM + wr * 64 + fr; int colt = u.pn * BM; bf16_t* base = O;
        float sc = 1.f; if (split_cols) { const int t = colt / split_cols; base += (size_t)t * split_stride; colt -= t * split_cols; if (t == 0) sc = scale0; }
        const int col0 = colt + wc * 32 + 8 * fq, bcol0 = u.pn * BM + wc * 32 + 8 * fq;
        f32x4 bv[2][2];
#pragma unroll
        for (int bj = 0; bj < 2; ++bj)
#pragma unroll
            for (int n = 0; n < 2; ++n) bv[bj][n] = bias ? *(const f32x4*)(bias + bcol0 + bj * HALF + 4 * n) : (f32x4){0.f, 0.f, 0.f, 0.f};
#pragma unroll
        for (int ai = 0; ai < 2; ++ai)
#pragma unroll
            for (int m = 0; m < 4; ++m) { bf16_t* rowp = base + (size_t)(row0 + ai * HALF + m * 16) * ldc + col0;
#pragma unroll
                for (int bj = 0; bj < 2; ++bj) { f32x4 v0 = acc[ai][bj][m][0] + bv[bj][0], v1 = acc[ai][bj][m][1] + bv[bj][1];
                    if (ACT == 1) { f32x2 a = gelu_pk((f32x2){v0[0], v0[1]}), b = gelu_pk((f32x2){v0[2], v0[3]}), c = gelu_pk((f32x2){v1[0], v1[1]}), d = gelu_pk((f32x2){v1[2], v1[3]});
                        v0 = (f32x4){a.x, a.y, b.x, b.y}; v1 = (f32x4){c.x, c.y, d.x, d.y}; }
                    v0 = v0 * sc; v1 = v1 * sc; u32x4 w; w.x = cvt_pk_bf16(v0[0], v0[1]); w.y = cvt_pk_bf16(v0[2], v0[3]); w.z = cvt_pk_bf16(v1[0], v1[1]); w.w = cvt_pk_bf16(v1[2], v1[3]);
                    *(u32x4*)(rowp + bj * HALF) = w; } }
    }
};
struct EpiResF32 {
    static constexpr bool PERM = false, AFTER_DRAIN = false;
    const float* base; float* out; int ldc;
    __device__ __forceinline__ void operator()(const f32x4 (&acc)[2][2][4][2], const Unit& u, int wr, int wc, int fr, int fq) const {
        const int col0 = u.pn * BM + wc * 32 + 4 * fq;
#pragma unroll
        for (int ai = 0; ai < 2; ++ai)
#pragma unroll
            for (int m = 0; m < 4; ++m) { const size_t off = (size_t)(u.pm * BM + ai * HALF + wr * 64 + m * 16 + fr) * ldc + col0;
#pragma unroll
                for (int bj = 0; bj < 2; ++bj)
#pragma unroll
                    for (int n = 0; n < 2; ++n) { const f32x4 bs = *(const f32x4*)(base + off + bj * HALF + n * 16); *(f32x4*)(out + off + bj * HALF + n * 16) = bs + acc[ai][bj][m][n]; }
                if (m & 1) asm volatile("" ::: "memory"); }
    }
};
template <class Epi, class Sched, bool ALIGN_EPI = false, bool SP2 = false>
__device__ __forceinline__ void gemm_phase(PG8_LAS unsigned char* lds, const Gemm g, const Sched& S, const Epi& E) {
    const int tid = threadIdx.x, wid = __builtin_amdgcn_readfirstlane(tid >> 6), lane = tid & 63, wr = wid >> 2, wc = wid & 3, fr = lane & 15, fq = lane >> 4;
    const int K = g.K, nt = K / BK;
    unsigned voffA[2], voffB[2];
#pragma unroll
    for (int i = 0; i < 2; ++i) { int R, C; stage_rc(tid * 16 + i * 8192, R, C); const int Rb = Epi::PERM ? ((R & ~31) + perm32(R & 31)) : R;
        voffA[i] = (unsigned)(R * g.lda + C) * 2u; voffB[i] = (unsigned)(Rb * g.ldb + C) * 2u; }
    const size_t kstep = (size_t)(BK * 2);
    const size_t hstepA = (size_t)HALF * g.lda * 2, hstepB = (size_t)HALF * g.ldb * 2;
    const size_t tstepA = 2 * hstepA, tstepB = 2 * hstepB;
    const unsigned ldsw = (unsigned)wid * 1024u;
    const int aoff = lds_byte(wr * 64 + fr, fq * 8), boff = lds_byte(wc * 32 + fr, fq * 8);
#define PG8_SA(b, h) (((b) * 2 + (h)) * HTB)
#define PG8_SB(b, h) ((4 + (b) * 2 + (h)) * HTB)
#define PG8_STAGE(bufoff, gbase, voff) do { _Pragma("unroll") for (int _i = 0; _i < 2; ++_i) \
        __builtin_amdgcn_global_load_lds((const unsigned*)((const char*)(gbase) + (voff)[_i]), (PG8_LAS unsigned*)(lds + (bufoff) + ldsw + _i * 8192), 16, 0, 0); } while (0)
#define PG8_LDA(dst, b, h) do { _Pragma("unroll") for (int m = 0; m < 4; ++m) _Pragma("unroll") for (int k = 0; k < 2; ++k) dst[m][k] = *(const PG8_LAS bf16x8*)(lds + PG8_SA(b, h) + aoff + m * 2048 + k * 1024); } while (0)
#define PG8_LDB(dst, b, h) do { _Pragma("unroll") for (int n = 0; n < 2; ++n) _Pragma("unroll") for (int k = 0; k < 2; ++k) dst[n][k] = *(const PG8_LAS bf16x8*)(lds + PG8_SB(b, h) + boff + n * 2048 + k * 1024); } while (0)
#define PG8_MMA(ai, bj, At, Bt) do { __builtin_amdgcn_s_setprio(1); _Pragma("unroll") for (int m = 0; m < 4; ++m) _Pragma("unroll") for (int n = 0; n < 2; ++n) _Pragma("unroll") for (int k = 0; k < 2; ++k) \
        acc[ai][bj][m][n] = __builtin_amdgcn_mfma_f32_16x16x32_bf16(Bt[n][k], At[m][k], acc[ai][bj][m][n], 0, 0, 0); __builtin_amdgcn_s_setprio(0); } while (0)
#define PG8_WAIT_V(n) asm volatile("s_waitcnt vmcnt(" #n ")" ::: "memory")
#define PG8_WAIT_L(n) asm volatile("s_waitcnt lgkmcnt(" #n ")" ::: "memory")
#define PG8_BAR __builtin_amdgcn_s_barrier()
#define PG8_SCHED __builtin_amdgcn_sched_barrier(0)
    Unit cur, nxt; int ui = 0;
    if (!S.next(0, cur)) return;
    f32x4 acc[2][2][4][2];
#pragma unroll
    for (int a = 0; a < 2; ++a)
#pragma unroll
        for (int b = 0; b < 2; ++b)
#pragma unroll
            for (int m = 0; m < 4; ++m)
#pragma unroll
                for (int n = 0; n < 2; ++n) acc[a][b][m][n] = (f32x4){0.f, 0.f, 0.f, 0.f};
    bf16x8 At[4][2], B0[2][2], B1[2][2];
    const char* cA = (const char*)g.A + (size_t)cur.pm * tstepA; const char* cB = (const char*)g.Bt + (size_t)cur.pn * tstepB;
    S.a_ready(cur);
    if constexpr (SP2) {
        PG8_STAGE(PG8_SB(0, 0), cB, voffB); PG8_STAGE(PG8_SB(0, 1), cB + hstepB, voffB); PG8_STAGE(PG8_SA(0, 0), cA, voffA); PG8_STAGE(PG8_SA(0, 1), cA + hstepA, voffA);
        if (wr == 1) PG8_BAR;
        PG8_WAIT_V(2); PG8_BAR;
        PG8_STAGE(PG8_SB(1, 0), cB + kstep, voffB); PG8_STAGE(PG8_SA(1, 0), cA + kstep, voffA); PG8_STAGE(PG8_SB(1, 1), cB + hstepB + kstep, voffB);
        PG8_WAIT_V(6); PG8_BAR;
    } else {
        PG8_STAGE(PG8_SB(0, 0), cB, voffB); PG8_STAGE(PG8_SA(0, 0), cA, voffA); PG8_STAGE(PG8_SB(0, 1), cB + hstepB, voffB); PG8_STAGE(PG8_SA(0, 1), cA + hstepA, voffA);
        if (wr == 1) PG8_BAR;
        PG8_WAIT_V(4); PG8_BAR;
        PG8_STAGE(PG8_SB(1, 0), cB + kstep, voffB); PG8_STAGE(PG8_SA(1, 0), cA + kstep, voffA); PG8_STAGE(PG8_SB(1, 1), cB + hstepB + kstep, voffB);
        PG8_WAIT_V(6); PG8_BAR;
    }
    for (;;) {
        const bool has_next = S.next(ui + 1, nxt);
        const char* nA = has_next ? (const char*)g.A + (size_t)nxt.pm * tstepA : cA; const char* nB = has_next ? (const char*)g.Bt + (size_t)nxt.pn * tstepB : cB;
        for (int t = 0; t < nt; t += 2) {
            const bool last = (t == nt - 2);
            const char* a1 = cA + (size_t)(t + 1) * kstep;
            const char* a2 = last ? nA : cA + (size_t)(t + 2) * kstep; const char* b2 = last ? nB : cB + (size_t)(t + 2) * kstep;
            const char* a3 = a2 + kstep; const char* b3 = b2 + kstep;
            if (last && has_next) S.a_ready(nxt);
            if constexpr (SP2) {
            PG8_LDB(B0, 0, 0); PG8_LDB(B1, 0, 1); PG8_SCHED; PG8_LDA(At, 0, 0); PG8_STAGE(PG8_SA(1, 1), a1 + hstepA, voffA);
            PG8_WAIT_V(8); PG8_WAIT_L(0); PG8_BAR; PG8_MMA(0, 0, At, B0); PG8_MMA(0, 1, At, B1); PG8_BAR; PG8_SCHED;
            PG8_LDA(At, 0, 1); PG8_STAGE(PG8_SB(0, 0), b2, voffB); PG8_STAGE(PG8_SB(0, 1), b2 + hstepB, voffB); PG8_STAGE(PG8_SA(0, 0), a2, voffA);
            PG8_WAIT_V(8); PG8_WAIT_L(0); PG8_BAR; PG8_MMA(1, 0, At, B0); PG8_MMA(1, 1, At, B1); PG8_BAR; PG8_SCHED;
            PG8_LDB(B0, 1, 0); PG8_LDB(B1, 1, 1); PG8_SCHED; PG8_LDA(At, 1, 0); PG8_STAGE(PG8_SA(0, 1), a2 + hstepA, voffA);
            PG8_WAIT_V(8); PG8_WAIT_L(0); PG8_BAR; PG8_MMA(0, 0, At, B0); PG8_MMA(0, 1, At, B1); PG8_BAR; PG8_SCHED;
            PG8_LDA(At, 1, 1); PG8_STAGE(PG8_SB(1, 0), b3, voffB); PG8_STAGE(PG8_SB(1, 1), b3 + hstepB, voffB); PG8_STAGE(PG8_SA(1, 0), a3, voffA);
            PG8_WAIT_V(8); PG8_WAIT_L(0); PG8_BAR; PG8_MMA(1, 0, At, B0); PG8_MMA(1, 1, At, B1); PG8_BAR; PG8_SCHED;
            } else {
            PG8_LDB(B0, 0, 0); PG8_SCHED; PG8_LDA(At, 0, 0); PG8_STAGE(PG8_SA(1, 1), a1 + hstepA, voffA);
            PG8_WAIT_L(8); PG8_BAR; PG8_WAIT_L(0); PG8_MMA(0, 0, At, B0); PG8_BAR; PG8_SCHED;
            PG8_LDB(B1, 0, 1); PG8_STAGE(PG8_SB(0, 0), b2, voffB);
            PG8_BAR; PG8_WAIT_L(0); PG8_MMA(0, 1, At, B1); PG8_BAR;
            PG8_LDA(At, 0, 1); PG8_STAGE(PG8_SA(0, 0), a2, voffA);
            PG8_BAR; PG8_WAIT_L(0); PG8_MMA(1, 0, At, B0); PG8_BAR; PG8_SCHED;
            PG8_STAGE(PG8_SB(0, 1), b2 + hstepB, voffB);
            PG8_WAIT_V(6); PG8_BAR; PG8_MMA(1, 1, At, B1); PG8_BAR;
            PG8_LDB(B0, 1, 0); PG8_SCHED; PG8_LDA(At, 1, 0); PG8_STAGE(PG8_SA(0, 1), a2 + hstepA, voffA);
            PG8_WAIT_L(8); PG8_BAR; PG8_WAIT_L(0); PG8_MMA(0, 0, At, B0); PG8_BAR; PG8_SCHED;
            PG8_LDB(B1, 1, 1); PG8_STAGE(PG8_SB(1, 0), b3, voffB);
            PG8_BAR; PG8_WAIT_L(0); PG8_MMA(0, 1, At, B1); PG8_BAR;
            PG8_LDA(At, 1, 1); PG8_STAGE(PG8_SA(1, 0), a3, voffA);
            PG8_BAR; PG8_WAIT_L(0); PG8_MMA(1, 0, At, B0); PG8_BAR; PG8_SCHED;
            PG8_STAGE(PG8_SB(1, 1), b3 + hstepB, voffB);
            PG8_WAIT_V(6); PG8_BAR; PG8_MMA(1, 1, At, B1); PG8_BAR;
            }
        }
        if constexpr (ALIGN_EPI) { if (wr == 0) PG8_BAR; }
        if constexpr (!Epi::AFTER_DRAIN) { E(acc, cur, wr, wc, fr, fq); S.done(cur); }
        if (!has_next) break;
#pragma unroll
        for (int a = 0; a < 2; ++a)
#pragma unroll
            for (int b = 0; b < 2; ++b)
#pragma unroll
                for (int m = 0; m < 4; ++m)
#pragma unroll
                    for (int n = 0; n < 2; ++n) acc[a][b][m][n] = (f32x4){0.f, 0.f, 0.f, 0.f};
        cur = nxt; cA = nA; cB = nB; ++ui;
        if constexpr (ALIGN_EPI) { if (wr == 1) PG8_BAR; }
    }
    PG8_WAIT_V(0);
    if constexpr (!ALIGN_EPI) { if (wr == 0) PG8_BAR; }
    PG8_BAR;
    if constexpr (Epi::AFTER_DRAIN) { E.fused(acc, cur, wr, wc, fr, fq, lds, wid, lane); S.done(cur); }
#undef PG8_SA
#undef PG8_SB
#undef PG8_STAGE
#undef PG8_LDA
#undef PG8_LDB
#undef PG8_MMA
#undef PG8_WAIT_V
#undef PG8_WAIT_L
#undef PG8_BAR
#undef PG8_SCHED
}
}

#ifndef PG8_SP2
#define PG8_SP2 true
#endif
#ifndef PG8_ALIGN
#define PG8_ALIGN true
#endif
#ifndef MK_N_LAUNCHES
#define MK_N_LAUNCHES 1
#endif

constexpr int NWAVES = 8;
constexpr int BATCH = 8, SEQ = 2048, DM = 1024, T = BATCH * SEQ;
constexpr int NPROJ = 6144, NPROJ_FULL = 6152;
constexpr int COL_XM = 0, COL_ZM = 1024, COL_QF = 2048, COL_KF = 3072, COL_VF = 4096, COL_ZF = 5120;
constexpr int DMIX = 2048;
constexpr float EPS = 1e-6f;
constexpr float FOX_SCALE = 0.08838834764831845f;
constexpr float FOX_ISCALE = 11.313708498984761f;
constexpr int N_PHASES = 8;

constexpr size_t MiB = 1u << 20;
constexpr size_t WS_CTL = 0, CTL_ZERO_BYTES = 1 * MiB;
constexpr size_t WS_WIN = 1 * MiB;
constexpr size_t WS_WOUT = 13 * MiB;
constexpr size_t WS_LFF = 17 * MiB;
constexpr size_t WS_UTAB = WS_LFF + 512 * 1024;
constexpr size_t WS_GATES = 18 * MiB;
constexpr size_t WS_WGE = WS_GATES + 512 * 1024;
constexpr size_t WS_STATS = 19 * MiB;
constexpr size_t WS_XCHG = 23 * MiB;
constexpr size_t WS_HN = 24 * MiB;
constexpr size_t WS_PROJ = 56 * MiB;
constexpr size_t WS_END = 248 * MiB;
static_assert(WS_PROJ + (size_t)T * NPROJ * 2 == WS_END && WS_HN + (size_t)T * DM * 2 == WS_PROJ, "d_ws map");
constexpr int CW_TMO = 0, CW_CODE = 1;
constexpr int CW_BAR = 4096;
constexpr int CW_SEAM = 16384;
constexpr int RING_OFF = 0, RING_BYTES = 131072;
constexpr int LDSCTL_OFF = RING_BYTES, MISC_OFF = LDSCTL_OFF + 320;
constexpr int LDS_BYTES = 147456;
#define GAS __attribute__((address_space(1)))
#define LAS __attribute__((address_space(3)))
typedef unsigned short bf16;
typedef unsigned v4u __attribute__((ext_vector_type(4)));
typedef float f32x4 __attribute__((ext_vector_type(4)));
typedef short bf16x8 __attribute__((ext_vector_type(8)));
typedef GAS unsigned gu32;
typedef GAS unsigned long long gu64;
#define RLX_AGENT __ATOMIC_RELAXED, __HIP_MEMORY_SCOPE_AGENT
#define LDS_WAIT() asm volatile("s_waitcnt lgkmcnt(0)" ::: "memory")
#define VM_WAIT() asm volatile("s_waitcnt vmcnt(0)" ::: "memory")
__device__ __forceinline__ unsigned long long rt() { return __builtin_amdgcn_s_memrealtime(); }
__device__ __forceinline__ unsigned f2bf(float f) { unsigned u = __builtin_bit_cast(unsigned, f); return (u + 0x7fffu + ((u >> 16) & 1u)) >> 16; }
__device__ __forceinline__ unsigned pk2(float lo, float hi) { return f2bf(lo) | (f2bf(hi) << 16); }

#define XB_TMO      128
#define XB_XCNT(j)  (256  + 64 * (j))
#define XB_XSUB(j)  (1280 + 64 * (j))
#define XB_XGEN(j)  (2304 + 64 * (j))
#define XB_TOP      3328
#define XB_TOPGEN   3392
#define XCD_BAR_WORDS 3456
#define XB_SPIN_CAP (1u << 18)

__device__ __forceinline__ unsigned xb_ld(unsigned* p)              { return __hip_atomic_load(p, __ATOMIC_RELAXED, __HIP_MEMORY_SCOPE_AGENT); }
__device__ __forceinline__ unsigned xb_add(unsigned* p, unsigned v) { return __hip_atomic_fetch_add(p, v, __ATOMIC_RELAXED, __HIP_MEMORY_SCOPE_AGENT); }
__device__ __forceinline__ unsigned xb_xcc_id() { return (unsigned)__builtin_amdgcn_s_getreg((3 << 11) | 20) & 0xFu; }
#define XB_SPIN(cond, bar) do { unsigned _sp = 0; while (cond) { __builtin_amdgcn_s_sleep(1); \
    if ((++_sp & 255u) == 0u) { if (xb_ld(&(bar)[XB_TMO])) break; if (_sp > XB_SPIN_CAP) { atomicAdd(&(bar)[XB_TMO], 1u); break; } } } } while (0)

struct XcdBarrier {
    unsigned* bar; unsigned x;
    volatile LAS unsigned* st;
};

__device__ __forceinline__ XcdBarrier xcd_barrier_post(unsigned* bar, volatile LAS unsigned* st) {
    XcdBarrier b; b.bar = bar; b.x = xb_xcc_id(); b.st = st;
    if (threadIdx.x == 0) (void)xb_add(&bar[XB_XCNT(b.x)], 1u);
    return b;
}
__device__ __forceinline__ void xcd_barrier_complete(unsigned* bar, unsigned x, unsigned& nloc, unsigned& nx) {
    const unsigned G = gridDim.x * gridDim.y * gridDim.z;
    unsigned sum, cnt, mine, sp = 0u;
    for (;;) {
        sum = 0u; cnt = 0u; mine = 0u;
#pragma unroll
        for (unsigned j = 0; j < 16; ++j) { const unsigned c = xb_ld(&bar[XB_XCNT(j)]); sum += c; cnt += (c > 0u) ? 1u : 0u; mine = (j == x) ? c : mine; }
        if (sum == G) break;
        __builtin_amdgcn_s_sleep(1);
        if ((++sp & 255u) == 0u) { if (xb_ld(&bar[XB_TMO])) break; if (sp > XB_SPIN_CAP) { atomicAdd(&bar[XB_TMO], 1u); break; } }
    }
    nloc = mine > 0u ? mine : 1u; nx = cnt > 0u ? cnt : 1u;
}

__device__ __forceinline__ void xcd_barrier(const XcdBarrier& b) {
    asm volatile("s_waitcnt vmcnt(0)" ::: "memory");
    __syncthreads();
    if (threadIdx.x == 0) {
        unsigned* bar = b.bar;
        __builtin_amdgcn_s_waitcnt(0);
        unsigned nloc = b.st[0], nx = b.st[1];
        if (nloc == 0u) { xcd_barrier_complete(bar, b.x, nloc, nx); b.st[0] = nloc; b.st[1] = nx; }
        const unsigned old = xb_add(&bar[XB_XSUB(b.x)], 1u);
        const unsigned gen = old / nloc;
        if (old + 1u == (gen + 1u) * nloc) {
            __builtin_amdgcn_fence(__ATOMIC_RELEASE, "agent");
            asm volatile("s_waitcnt vmcnt(0)" ::: "memory");
            const unsigned og = xb_add(&bar[XB_TOP], 1u);
            const unsigned tg = og / nx;
            if (og + 1u == (tg + 1u) * nx) xb_add(&bar[XB_TOPGEN], 1u);
            else XB_SPIN(xb_ld(&bar[XB_TOPGEN]) == tg, bar);
            __builtin_amdgcn_fence(__ATOMIC_ACQUIRE, "agent");
            xb_add(&bar[XB_XGEN(b.x)], 1u);
            asm volatile("s_waitcnt vmcnt(0)" ::: "memory");
        } else {
            XB_SPIN(xb_ld(&bar[XB_XGEN(b.x)]) == gen, bar);
            __builtin_amdgcn_fence(__ATOMIC_ACQUIRE, "agent");
            asm volatile("s_waitcnt vmcnt(0)" ::: "memory");
        }
    }
    __syncthreads();
}

namespace fox {
constexpr int D = 128, PITCH = NPROJ;
constexpr float SCALE = FOX_SCALE, THR = 8.f;
constexpr int NW = 8, QBLK = 32, KVBLK = 64, QB = NW * QBLK;
constexpr int SHM_V = KVBLK * D * 2, SHM_K = KVBLK * D * 2;
constexpr int LDS_WS = 2 * SHM_V + 2 * SHM_K;
constexpr int LDS_UT = LDS_WS + NW * 64 * 4;
constexpr int LDS_BYTES_FOX = LDS_UT + SEQ * 4;
typedef short bf16x8 __attribute__((ext_vector_type(8)));
typedef short s16x4 __attribute__((ext_vector_type(4)));
typedef float f32x16 __attribute__((ext_vector_type(16)));
typedef float f32x4 __attribute__((ext_vector_type(4)));
typedef unsigned u32x4 __attribute__((ext_vector_type(4)));
typedef unsigned short bf;

#define KSWZ(row, colB) ((row) * 256 + ((colB) ^ (((row) & 7) << 4)))
#define SBAR() __builtin_amdgcn_sched_barrier(0)
__device__ __forceinline__ int v_st(int k, int c) { const int kk = (k & ~0xC) | ((k & 4) << 1) | ((k & 8) >> 1); return ((kk >> 3) * 4 + (c >> 5)) * 512 + ((kk & 7) * 32 + (c & 31)) * 2; }
__device__ __forceinline__ int v_rd_base(int lane) { return ((lane & 3) << 3) | (((lane >> 2) & 3) << 6) | (((lane >> 4) & 1) << 5) | (((lane >> 5) & 1) << 8); }
constexpr int v_rd_off(int d0, int ks, int half) { return d0 * 512 + ks * 4096 + half * 2048; }
__device__ __forceinline__ int crow(int r, int hi) { return (r & 3) + 8 * (r >> 2) + 4 * hi; }
__device__ __forceinline__ unsigned cvtpk(float lo, float hi) { unsigned r; asm volatile("v_cvt_pk_bf16_f32 %0, %1, %2" : "=v"(r) : "v"(lo), "v"(hi)); return r; }
__device__ __forceinline__ bf16x8 load8(const bf* p) { return *reinterpret_cast<const bf16x8*>(p); }
__device__ __forceinline__ void mask_tile(f32x16& p0, f32x16& p1, int dq, unsigned W) {
    const float NEG = -__builtin_inff();
#pragma unroll
    for (int r = 0; r < 16; ++r) {
        const int c = (r & 3) + 8 * (r >> 2);
        if ((unsigned)(dq - c) >= W) p0[r] = NEG;
        if ((unsigned)(dq - c - 32) >= W) p1[r] = NEG;
    }
}
__device__ __forceinline__ void partialSM(f32x16& p0, f32x16& p1, float& m_reg, float& mn, float& alpha) {
    float pmax = p0[0]; for (int r = 1; r < 16; ++r) pmax = fmaxf(pmax, p0[r]); for (int r = 0; r < 16; ++r) pmax = fmaxf(pmax, p1[r]);
    { auto rr = __builtin_amdgcn_permlane32_swap(__float_as_uint(pmax), __float_as_uint(pmax), false, false);
      pmax = fmaxf(__uint_as_float(rr[0]), __uint_as_float(rr[1])); }
    constexpr float C2 = 1.4426950408889634f * SCALE;
    if (__builtin_expect(__all((pmax - m_reg) * SCALE <= THR), 1)) { mn = m_reg; alpha = 1.f; }
    else { mn = fmaxf(m_reg, pmax); alpha = __builtin_amdgcn_exp2f((m_reg - mn) * C2); m_reg = mn; }
    const float mnL = -mn * C2;
    for (int r = 0; r < 16; ++r) p0[r] = fmaf(p0[r], C2, mnL); for (int r = 0; r < 16; ++r) p1[r] = fmaf(p1[r], C2, mnL);
    for (int r = 0; r < 16; ++r) p0[r] = __builtin_amdgcn_exp2f(p0[r]);
}
__device__ __forceinline__ void finishSM(f32x16& p0, f32x16& p1, float alpha, float& l_reg, bf16x8& pa0, bf16x8& pa1, bf16x8& pa2, bf16x8& pa3) {
    for (int r = 0; r < 16; ++r) p1[r] = __builtin_amdgcn_exp2f(p1[r]);
    float ps = 0; for (int r = 0; r < 16; ++r) ps += p0[r]; for (int r = 0; r < 16; ++r) ps += p1[r];
    { auto rr = __builtin_amdgcn_permlane32_swap(__float_as_uint(ps), __float_as_uint(ps), false, false);
      ps = __uint_as_float(rr[0]) + __uint_as_float(rr[1]); }
    l_reg = l_reg * alpha + ps;
#define PK4(P, B_, OUT) do { unsigned a0 = cvtpk(P[B_+0], P[B_+1]), a1 = cvtpk(P[B_+2], P[B_+3]);                          \
        unsigned b0 = cvtpk(P[B_+4], P[B_+5]), b1 = cvtpk(P[B_+6], P[B_+7]);                                             \
        auto r0 = __builtin_amdgcn_permlane32_swap(a0, b0, false, false); auto r1 = __builtin_amdgcn_permlane32_swap(a1, b1, false, false); \
        u32x4 w = {r0[0], r1[0], r0[1], r1[1]}; OUT = *reinterpret_cast<bf16x8*>(&w); } while (0)
    PK4(p0, 0, pa0); PK4(p0, 8, pa1); PK4(p1, 0, pa2); PK4(p1, 8, pa3);
#undef PK4
}
template <int KB>
__device__ __forceinline__ void qkt(f32x16& p0, f32x16& p1, const char* K_lds, int r32, int hi, const bf16x8* qr, const LAS float* ub) {
#pragma unroll
    for (int g = 0; g < 4; ++g) { const f32x4 a = *(const LAS f32x4*)(ub + 8 * g), b = *(const LAS f32x4*)(ub + 32 + 8 * g);
        p0[4 * g] = a.x; p0[4 * g + 1] = a.y; p0[4 * g + 2] = a.z; p0[4 * g + 3] = a.w; p1[4 * g] = b.x; p1[4 * g + 1] = b.y; p1[4 * g + 2] = b.z; p1[4 * g + 3] = b.w; }
    const char* kb[4];
#pragma unroll
    for (int dd = 0; dd < 4; ++dd) kb[dd] = K_lds + KB * SHM_K + KSWZ(r32, (dd * 16 + hi * 8) * 2);
#pragma unroll
    for (int d0 = 0; d0 < 8; ++d0) { const char* a = kb[d0 & 3] + (d0 >> 2) * 128;
        bf16x8 b0 = *reinterpret_cast<const bf16x8*>(a);
        bf16x8 b1 = *reinterpret_cast<const bf16x8*>(a + 32 * 256);
        p0 = __builtin_amdgcn_mfma_f32_32x32x16_bf16(b0, qr[d0], p0, 0, 0, 0);
        p1 = __builtin_amdgcn_mfma_f32_32x32x16_bf16(b1, qr[d0], p1, 0, 0, 0); }
}
template <int VB>
__device__ __forceinline__ void pv_tile(f32x16* o, int vb0, bf16x8 pa0, bf16x8 pa1, bf16x8 pa2, bf16x8 pa3) {
#define TRRD(dst, off) asm volatile("ds_read_b64_tr_b16 %0, %1 offset:%2" : "=&v"(dst) : "v"(vb0), "i"(off) : "memory")
#define PV_D0(d0) do { s16x4 l0, l1, l2, l3, h0, h1, h2, h3; constexpr int b_ = VB * SHM_V + v_rd_off(d0, 0, 0); \
        TRRD(l0, b_); TRRD(h0, b_ + 2048); TRRD(l1, b_ + 4096); TRRD(h1, b_ + 6144); TRRD(l2, b_ + 8192); TRRD(h2, b_ + 10240); TRRD(l3, b_ + 12288); TRRD(h3, b_ + 14336); \
        asm volatile("s_waitcnt lgkmcnt(0)" ::: "memory"); SBAR();   \
        o[d0] = __builtin_amdgcn_mfma_f32_32x32x16_bf16(pa0, (bf16x8){l0[0], l0[1], l0[2], l0[3], h0[0], h0[1], h0[2], h0[3]}, o[d0], 0, 0, 0);   \
        o[d0] = __builtin_amdgcn_mfma_f32_32x32x16_bf16(pa1, (bf16x8){l1[0], l1[1], l1[2], l1[3], h1[0], h1[1], h1[2], h1[3]}, o[d0], 0, 0, 0);   \
        o[d0] = __builtin_amdgcn_mfma_f32_32x32x16_bf16(pa2, (bf16x8){l2[0], l2[1], l2[2], l2[3], h2[0], h2[1], h2[2], h2[3]}, o[d0], 0, 0, 0);   \
        o[d0] = __builtin_amdgcn_mfma_f32_32x32x16_bf16(pa3, (bf16x8){l3[0], l3[1], l3[2], l3[3], h3[0], h3[1], h3[2], h3[3]}, o[d0], 0, 0, 0); } while (0)
    PV_D0(0); PV_D0(1); PV_D0(2); PV_D0(3);
#undef PV_D0
#undef TRRD
}
struct BlockRef { const bf* Q; const bf* K; const bf* V; bf* O; const bf* Z; int P0; int hcol; };
struct Seam { bf16x8 qr[8]; bf16x8 st_v0, st_v1, st_k0, st_k1; };
#define ROW(p, k0, rr) ((p) + (size_t)((k0) + (rr)) * PITCH + sc)
#define VMW() asm volatile("s_waitcnt vmcnt(0)" ::: "memory")
#define VMWN(n) asm volatile("s_waitcnt vmcnt(%0)" :: "i"(n) : "memory")
#define SLOAD_H(Kp, Vp, k0) do { S.st_v0 = load8(ROW(Vp, k0, sr)); S.st_v1 = load8(ROW(Vp, k0, 32 + sr));              \
                         S.st_k0 = load8(ROW(Kp, k0, sr)); S.st_k1 = load8(ROW(Kp, k0, 32 + sr)); } while (0)
#define SWRITE_HK(bf_) do { *(bf16x8*)(K_lds + (bf_) * SHM_K + kws) = S.st_k0; *(bf16x8*)(K_lds + (bf_) * SHM_K + kws + 32 * 256) = S.st_k1; } while (0)
#define SWRITE_HV(bf_) do { *(bf16x8*)(V_lds + (bf_) * SHM_V + vst0) = S.st_v0; *(bf16x8*)(V_lds + (bf_) * SHM_V + vst1) = S.st_v1; } while (0)
#define SWRITE_H(bf_) do { SWRITE_HV(bf_); SWRITE_HK(bf_); } while (0)
__device__ __forceinline__ void fox_prime(const BlockRef& cur, char* lds, Seam& S) {
    int tid_ = threadIdx.x; asm volatile("" : "+v"(tid_));
    const int tid = tid_, wid = __builtin_amdgcn_readfirstlane(tid >> 6), lane = tid & 63, r32 = lane & 31, hi = lane >> 5;
    const int sr = tid >> 4, sc = (tid & 15) * 8, kws = KSWZ(sr, sc * 2); char* K_lds = lds + 2 * SHM_V;
    const int kb0 = 0;
    for (int d0 = 0; d0 < 8; ++d0) S.qr[d0] = load8(cur.Q + (size_t)(wid * QBLK + r32) * PITCH + d0 * 16 + hi * 8);
    SLOAD_H(cur.K, cur.V, kb0); VMW(); SWRITE_HK(0);
    __syncthreads();
}
__device__ __forceinline__ void fox_block(const BlockRef& cur, const BlockRef& nxt, char* lds, const LAS float* ut, Seam& S, const float* gain) {
    int tid_ = threadIdx.x; asm volatile("" : "+v"(tid_));
    const int tid = tid_, wid = __builtin_amdgcn_readfirstlane(tid >> 6), lane = tid & 63, r32 = lane & 31, hi = lane >> 5;
    const int W = 1 << 20;
    const int j_lo = 0;
    const int j_hi = (cur.P0 + QB - 1) / KVBLK + 1;
    const int NT = j_hi - j_lo;
    const int kbn = 0;
    const int qlo = cur.P0 + wid * QBLK, qm = qlo + r32 - 4 * hi;
    char* V_lds = lds; char* K_lds = lds + 2 * SHM_V;
    float* ws = (float*)(lds + LDS_WS) + wid * 64; float* li_l = ws, * al_l = ws + 32;
    float m_reg = -1e30f, l_reg = 0; f32x16 o[4] = {};
    const int sr = tid >> 4, sc = (tid & 15) * 8, vst0 = v_st(sr, sc), vst1 = v_st(32 + sr, sc), kws = KSWZ(sr, sc * 2);
    const int vb0 = (int)(uintptr_t)V_lds + v_rd_base(lane);
    const bf* Kh = cur.K; const bf* Vh = cur.V;
    const LAS float* ub = ut + 4 * hi;
#define RESC(a) do { if (__any((a) < 1.f)) { if (hi == 0) al_l[r32] = (a); asm volatile("s_waitcnt lgkmcnt(0)" ::: "memory");              \
                     for (int d_ = 0; d_ < 4; ++d_) for (int r = 0; r < 16; ++r) o[d_][r] *= al_l[crow(r, hi)]; } } while (0)
#define KBASE(t) ((j_lo + (t)) * KVBLK)
#define MASKT(P0_, P1_, t) do { const int kb_ = KBASE(t); if (kb_ + KVBLK - 1 > qlo) mask_tile(P0_, P1_, qm - kb_, (unsigned)W); } while (0)
    constexpr int NQL = 8;
#define SEAM_K0() do { VMWN(NQL); SWRITE_HK(0); SBAR(); } while (0)
    f32x16 pA0, pA1, pB0, pB1; float mnA, mnB, alA, alB; bf16x8 pa0, pa1, pa2, pa3;
    SWRITE_HV(0); SBAR();
    if (NT > 1) { SLOAD_H(Kh, Vh, KBASE(1)); }
    SBAR(); qkt<0>(pA0, pA1, K_lds, r32, hi, S.qr, ub + KBASE(0));
    MASKT(pA0, pA1, 0); partialSM(pA0, pA1, m_reg, mnA, alA);
    if (NT > 1) { VMW(); SWRITE_H(1); }
    __syncthreads();
#define HALF_STEP(PX0, PX1, mnX, alX, PY0, PY1, alY, t, KB, VB, SB) do {                                                      \
        SBAR(); qkt<KB>(PX0, PX1, K_lds, r32, hi, S.qr, ub + KBASE(t));                                                       \
        finishSM(PY0, PY1, alY, l_reg, pa0, pa1, pa2, pa3); SBAR();                                                           \
        if ((t) + 1 < NT) { SLOAD_H(Kh, Vh, KBASE((t) + 1)); SBAR(); }                                                        \
        pv_tile<VB>(o, vb0, pa0, pa1, pa2, pa3); MASKT(PX0, PX1, (t)); partialSM(PX0, PX1, m_reg, mnX, alX);                  \
        __syncthreads();                                                                                                      \
        if ((t) + 1 < NT) { VMW(); SWRITE_H(SB); }                                                                            \
        RESC(alX); __syncthreads(); } while (0)
    for (int t = 1; t + 1 < NT; t += 2) {
        HALF_STEP(pB0, pB1, mnB, alB, pA0, pA1, alA, t, 1, 0, 0);
        HALF_STEP(pA0, pA1, mnA, alA, pB0, pB1, alB, t + 1, 0, 1, 1);
    }
    const bool even = (NT & 1) == 0;
    if (even) { SBAR(); qkt<1>(pB0, pB1, K_lds, r32, hi, S.qr, ub + KBASE(NT - 1)); SBAR(); }
    SLOAD_H(nxt.K, nxt.V, kbn); SBAR();
#pragma unroll
    for (int d0 = 0; d0 < 8; ++d0) S.qr[d0] = load8(nxt.Q + (size_t)(wid * QBLK + r32) * PITCH + d0 * 16 + hi * 8);
    SBAR();
    finishSM(pA0, pA1, alA, l_reg, pa0, pa1, pa2, pa3); SBAR();
    pv_tile<0>(o, vb0, pa0, pa1, pa2, pa3);
    if (even) { MASKT(pB0, pB1, NT - 1); partialSM(pB0, pB1, m_reg, mnB, alB); __syncthreads(); RESC(alB);
        finishSM(pB0, pB1, alB, l_reg, pa0, pa1, pa2, pa3); SBAR(); pv_tile<1>(o, vb0, pa0, pa1, pa2, pa3); }
    SBAR(); SEAM_K0();
    if (hi == 0) li_l[r32] = l_reg; asm volatile("s_waitcnt lgkmcnt(0)" ::: "memory");
    float rs[16];
#pragma unroll
    for (int r = 0; r < 16; ++r) { const float rl = __builtin_amdgcn_rcpf(li_l[crow(r, hi)]);
        float q = 0.f;
#pragma unroll
        for (int d0 = 0; d0 < 4; ++d0) { o[d0][r] *= rl; q += o[d0][r] * o[d0][r]; }
        q += __shfl_xor(q, 1); q += __shfl_xor(q, 2); q += __shfl_xor(q, 4); q += __shfl_xor(q, 8); q += __shfl_xor(q, 16);
        rs[r] = 1.0f / sqrtf(q * (1.f / 128.f) + EPS); }
    float gn[4];
#pragma unroll
    for (int d0 = 0; d0 < 4; ++d0) gn[d0] = gain[cur.hcol + d0 * 32 + r32];
    bf* Ow = cur.O + (size_t)(wid * QBLK) * PITCH; const bf* Zw = cur.Z + (size_t)(wid * QBLK) * PITCH;
#pragma unroll
    for (int r = 0; r < 16; ++r) { const int orow = crow(r, hi);
#pragma unroll
        for (int d0 = 0; d0 < 4; ++d0) {
            const float z = __uint_as_float((unsigned)Zw[(size_t)orow * PITCH + d0 * 32 + r32] << 16);
            const float v = (o[d0][r] * rs[r]) * gn[d0] * (z / (1.f + __expf(-z)));
            const float vn = __shfl_xor(v, 1);
            if ((r32 & 1) == 0) *(unsigned*)(Ow + (size_t)orow * PITCH + d0 * 32 + r32) = cvtpk(v, vn); } }
    __syncthreads();
#undef RESC
#undef KBASE
#undef MASKT
#undef SEAM_K0
#undef HALF_STEP
}
#undef ROW
#undef VMW
#undef VMWN
#undef SLOAD_H
#undef SWRITE_HK
#undef SWRITE_HV
#undef SWRITE_H
__device__ __forceinline__ BlockRef fox_ref(bf* PROJ, int L, int pass) {
    const int bh = L >> 2, x = L & 3, qb = pass ? 7 - x : x, b = bh >> 3, h = bh & 7;
    BlockRef r; bf* base = PROJ + (size_t)b * SEQ * PITCH;
    r.Q = base + (size_t)qb * QB * PITCH + COL_QF + h * D; r.O = (bf*)r.Q; r.Z = base + (size_t)qb * QB * PITCH + COL_ZF + h * D;
    r.K = base + COL_KF + h * D; r.V = base + COL_VF + h * D; r.P0 = qb * QB; r.hcol = h * D;
    return r;
}
__device__ __forceinline__ void fox_phase(char* lds, LAS unsigned char* lds3, unsigned char* ws, const float* gain, int G, int vcu) {
    bf* PROJ = (bf*)(ws + WS_PROJ); const float* UTAB = (const float*)(ws + WS_UTAB);
    const int total = BATCH * 8 * 4, stride = G;
    int L = vcu; if (L >= total) return;
    int tix = threadIdx.x; asm volatile("" : "+v"(tix));
    LAS float* ut = (LAS float*)(lds3 + LDS_UT);
    int pass = 0, bh_loaded = -1;
    BlockRef cur = fox_ref(PROJ, L, 0);
    Seam S;
    { const int bh = L >> 2; const f32x4 u = *(const f32x4*)(UTAB + (size_t)bh * SEQ + 4 * tix); *(LAS f32x4*)(ut + 4 * tix) = u; bh_loaded = bh; }
    fox_prime(cur, lds, S);
    for (;;) {
        const bool more_pass = pass == 0, more_item = L + stride < total, last = !more_pass && !more_item;
        int passn = pass + 1, Ln = L;
        if (!more_pass) { passn = 0; Ln = more_item ? L + stride : L; }
        const BlockRef nxt = last ? cur : fox_ref(PROJ, Ln, passn);
        fox_block(cur, nxt, lds, ut, S, gain);
        if (last) break;
        cur = nxt; pass = passn; L = Ln;
        if ((L >> 2) != bh_loaded) {
            const int bh = L >> 2; const f32x4 u = *(const f32x4*)(UTAB + (size_t)bh * SEQ + 4 * tix); *(LAS f32x4*)(ut + 4 * tix) = u; bh_loaded = bh; __syncthreads(); }
    }
}
#undef KSWZ
#undef SBAR
}

namespace mls {
typedef short bf16x8 __attribute__((ext_vector_type(8)));
typedef short s16x4 __attribute__((ext_vector_type(4)));
typedef short v4i16_t __attribute__((ext_vector_type(4)));
typedef float f32x16 __attribute__((ext_vector_type(16)));
typedef float f32x4 __attribute__((ext_vector_type(4)));
typedef float f32x2 __attribute__((ext_vector_type(2)));
typedef unsigned u32x4 __attribute__((ext_vector_type(4)));
typedef unsigned u32x2 __attribute__((ext_vector_type(2)));
typedef unsigned short bf;
typedef float f32x2_t __attribute__((ext_vector_type(2))); typedef __bf16 bf16x2_t __attribute__((ext_vector_type(2)));
__device__ __forceinline__ unsigned cvtpk_s(float lo, float hi) { f32x2_t v = {lo, hi}; bf16x2_t b = __builtin_convertvector(v, bf16x2_t); return __builtin_bit_cast(unsigned, b); }
__device__ __forceinline__ float lo16(unsigned w) { return __uint_as_float(w << 16); }
__device__ __forceinline__ float hi16(unsigned w) { return __uint_as_float(w & 0xffff0000u); }
template <int XM> __device__ __forceinline__ float swz_xor(float v) { return __int_as_float(__builtin_amdgcn_ds_swizzle(__float_as_int(v), 0x1f | (XM << 10))); }
__device__ __forceinline__ float dpp_scan_add(float v) {
#define DPP_STEP(ctrl, rm) v += __int_as_float(__builtin_amdgcn_update_dpp(0, __float_as_int(v), ctrl, rm, 0xf, false))
    DPP_STEP(0x111, 0xf); DPP_STEP(0x112, 0xf); DPP_STEP(0x114, 0xf); DPP_STEP(0x118, 0xf); DPP_STEP(0x142, 0xa); DPP_STEP(0x143, 0xc);
#undef DPP_STEP
    return v; }
__device__ __forceinline__ float dpp_scan_max(float v) {
#define DPP_STEP(ctrl, rm) v = fmaxf(v, __int_as_float(__builtin_amdgcn_update_dpp((int)0xff800000u, __float_as_int(v), ctrl, rm, 0xf, false)))
    DPP_STEP(0x111, 0xf); DPP_STEP(0x112, 0xf); DPP_STEP(0x114, 0xf); DPP_STEP(0x118, 0xf); DPP_STEP(0x142, 0xa); DPP_STEP(0x143, 0xc);
#undef DPP_STEP
    return v; }
__device__ __forceinline__ float rdlane63(float v) { return __int_as_float(__builtin_amdgcn_readlane(__float_as_int(v), 63)); }
constexpr int QP = 520;
constexpr int L_QT = 0, L_KT = 64 * QP, L_VT = 2 * 64 * QP, L_WVT = L_VT + 4096, L_SC = L_WVT + 4096, SC_FLOATS = 384;
constexpr int L_NL = L_SC + 2 * SC_FLOATS * 4, L_NP = L_NL + 1024, L_QN = L_NP + 4096, L_RSP = L_QN + 256, L_PART = L_RSP + 2048, L_END = L_PART + 32768;
static_assert(L_END <= RING_BYTES && (L_SC % 16) == 0 && (L_PART % 16) == 0 && (L_NL % 16) == 0 && (L_QN % 16) == 0 && (L_RSP % 16) == 0, "mLSTM LDS map");
constexpr int SC_AL = 0, SC_BE = 64, SC_W = 128, SC_WI = 192, SC_EM = 256, SC_DEC = 320;
constexpr float LOG2E = 1.4426950408889634f;
__device__ __forceinline__ int crow(int r, int hi) { return (r & 3) + 8 * (r >> 2) + 4 * hi; }
__device__ __forceinline__ s16x4 trrd(const LAS unsigned char* p) { return __builtin_bit_cast(s16x4, __builtin_amdgcn_ds_read_tr16_b64_v4i16((LAS v4i16_t*)p)); }
__device__ __forceinline__ bf16x8 cat8(s16x4 a, s16x4 b) { return (bf16x8){a[0], a[1], a[2], a[3], b[0], b[1], b[2], b[3]}; }
#define MLS_PK4(P, B_, OUT) do { unsigned a0 = cvtpk_s(P[B_+0], P[B_+1]), a1 = cvtpk_s(P[B_+2], P[B_+3]);                          \
        unsigned b0 = cvtpk_s(P[B_+4], P[B_+5]), b1 = cvtpk_s(P[B_+6], P[B_+7]);                                             \
        auto r0 = __builtin_amdgcn_permlane32_swap(a0, b0, false, false); auto r1 = __builtin_amdgcn_permlane32_swap(a1, b1, false, false); \
        u32x4 w_ = {r0[0], r1[0], r0[1], r1[1]}; OUT = __builtin_bit_cast(bf16x8, w_); } while (0)

__device__ __forceinline__ void mlstm_item(LAS unsigned char* lds, unsigned char* ws, const bf* QM, const float* w_v_m, int item) {
    int tid_ = threadIdx.x; asm volatile("" : "+v"(tid_));
    const int tid = tid_, lane = tid & 63, wid = __builtin_amdgcn_readfirstlane(tid >> 6), r32 = lane & 31, hi = lane >> 5;
    const int bh = item >> 3, eb = item & 7, b = bh >> 2, h = bh & 3;
    const size_t trow0 = (size_t)b * SEQ;
    const bf* QMh = QM + trow0 * DM + h * 256; const bf* KMh = QMh + (size_t)T * DM;
    bf* XMh = (bf*)(ws + WS_PROJ) + trow0 * NPROJ + COL_XM + h * 256 + eb * 32;
    const float* Gt = (const float*)(ws + WS_GATES) + trow0 * 8;
    float* STt = (float*)(ws + WS_STATS) + (trow0 * 4 + h) * 16 + eb * 2;
    LAS unsigned char* QT = lds + L_QT; LAS unsigned char* KT = lds + L_KT; LAS unsigned char* VT = lds + L_VT; LAS unsigned char* WVT = lds + L_WVT;
    LAS float* SC = (LAS float*)(lds + L_SC); LAS float* NL = (LAS float*)(lds + L_NL); LAS float* NP = (LAS float*)(lds + L_NP);
    LAS float* QN = (LAS float*)(lds + L_QN); LAS float* RSP = (LAS float*)(lds + L_RSP); LAS unsigned char* PART = lds + L_PART;
    const float* wvp = w_v_m + (size_t)(h * 64 + eb * 8 + (tid & 7)) * 16;
    f32x16 Cst = {};
    float nreg = 0.f, m_run = 0.f;
    u32x4 pq[4], pk[4]; u32x2 px; float p_ig = 0.f, p_lf = 0.f;
    const int li = lane & 15, tq = li >> 2, tp = li & 3, tcb = (lane >> 4) & 1;
    const int voff = (8 * hi + tq) * 64 + (16 * tcb + 4 * tp) * 2;
    const int koff = (8 * hi + tq) * QP + (32 * wid + 16 * tcb + 4 * tp) * 2;
    const unsigned loff = (unsigned)((tid >> 5) * (DM * 2) + (tid & 31) * 16);
    const unsigned xoff = (unsigned)((tid >> 3) * (NPROJ * 2) + (tid & 7) * 8);
#define LOAD_GATES(c_) do { if (wid == 7) { const float* g_ = Gt + (size_t)(c_) * 64 * 8; p_ig = g_[lane * 8 + h]; p_lf = g_[lane * 8 + 4 + h]; } } while (0)
#define LOAD_TILES(c_) do { const char* qb_ = (const char*)QMh + (size_t)(c_) * 64 * DM * 2; const char* kb_ = (const char*)KMh + (size_t)(c_) * 64 * DM * 2;     \
        _Pragma("unroll") for (int u = 0; u < 4; ++u) { pq[u] = *(const u32x4*)(qb_ + (size_t)u * 16 * DM * 2 + loff); pk[u] = *(const u32x4*)(kb_ + (size_t)u * 16 * DM * 2 + loff); } \
        px = *(const u32x2*)((const char*)XMh + (size_t)(c_) * 64 * NPROJ * 2 + xoff); } while (0)
#define TILE_WRITE() do { _Pragma("unroll") for (int u = 0; u < 4; ++u) { const int id = tid + 512 * u, row = id >> 5, ch = id & 31;        \
            *(LAS u32x2*)(QT + row * QP + ch * 16) = (u32x2){pq[u].x, pq[u].y}; *(LAS u32x2*)(QT + row * QP + ch * 16 + 8) = (u32x2){pq[u].z, pq[u].w}; \
            *(LAS u32x2*)(KT + row * QP + ch * 16) = (u32x2){pk[u].x, pk[u].y}; *(LAS u32x2*)(KT + row * QP + ch * 16 + 8) = (u32x2){pk[u].z, pk[u].w}; } } while (0)
#define V_WRITE(buf_) do { float wv[16];                                                                                                               \
        _Pragma("unroll") for (int i = 0; i < 4; ++i) { const f32x4 a_ = *(const f32x4*)(wvp + 4 * i); wv[4 * i] = a_.x; wv[4 * i + 1] = a_.y; wv[4 * i + 2] = a_.z; wv[4 * i + 3] = a_.w; } \
        const int j_ = tid >> 3, n_ = tid & 7; const float x0 = lo16(px.x), x1 = hi16(px.x), x2 = lo16(px.y), x3 = hi16(px.y);   \
        const float v0 = x0 * wv[0] + x1 * wv[4] + x2 * wv[8] + x3 * wv[12], v1 = x0 * wv[1] + x1 * wv[5] + x2 * wv[9] + x3 * wv[13];                \
        const float v2 = x0 * wv[2] + x1 * wv[6] + x2 * wv[10] + x3 * wv[14], v3 = x0 * wv[3] + x1 * wv[7] + x2 * wv[11] + x3 * wv[15];               \
        const float wj_ = SC[(buf_) * SC_FLOATS + SC_W + j_];                                                                                          \
        *(LAS u32x2*)(VT + j_ * 64 + n_ * 8) = (u32x2){cvtpk_s(v0, v1), cvtpk_s(v2, v3)};                                                             \
        *(LAS u32x2*)(WVT + j_ * 64 + n_ * 8) = (u32x2){cvtpk_s(wj_ * v0, wj_ * v1), cvtpk_s(wj_ * v2, wj_ * v3)}; } while (0)
#define SCALARS(buf_) do { if (wid == 7) { LAS float* sc_ = SC + (buf_) * SC_FLOATS;                                             \
        const float bc = dpp_scan_add(p_lf);                                                                                    \
        const float g_ = rdlane63(bc);                                                                                          \
        const float a_ = g_ - bc + p_ig; const float amax = rdlane63(dpp_scan_max(a_));                                          \
        const float m_new = fmaxf(g_ + m_run, amax);                                                                             \
        const float be = p_ig - bc; const float pm = dpp_scan_max(be);                                                           \
        const float mx = fmaxf(m_run, pm);                                                                                       \
        sc_[SC_AL + lane] = -mx * LOG2E; sc_[SC_BE + lane] = be * LOG2E; sc_[SC_W + lane] = expf(a_ - m_new);                     \
        sc_[SC_WI + lane] = expf(m_run - mx); sc_[SC_EM + lane] = expf(-(bc + mx));                                               \
        if (lane == 0) sc_[SC_DEC] = expf(g_ + m_run - m_new);                                                                   \
        m_run = m_new; } } while (0)

    LOAD_GATES(0); LOAD_TILES(0);
    if (tid < 256) NL[tid] = 0.f;
    SCALARS(0);
    TILE_WRITE();
    __syncthreads();
    V_WRITE(0);
    __syncthreads();

    for (int c = 0; c < SEQ / 64; ++c) {
        const LAS float* sc = SC + (c & 1) * SC_FLOATS;
        if (c + 1 < SEQ / 64) LOAD_GATES(c + 1);
        {
#define MLS_SB() __builtin_amdgcn_sched_barrier(0)
#define MLS_FRAG(dst, base, a_, s_) do { const LAS unsigned char* p_ = (base) + (32 * (a_) + r32) * QP + (32 * wid + 16 * (s_) + 4 * hi) * 2; \
            const u32x2 x0_ = *(const LAS u32x2*)p_, x1_ = *(const LAS u32x2*)(p_ + 16); dst = __builtin_bit_cast(bf16x8, (u32x4){x0_.x, x0_.y, x1_.x, x1_.y}); } while (0)
#define MLS_VF(dst, base, K_) dst = cat8(trrd((base) + voff + (K_) * 16 * 64), trrd((base) + voff + (K_) * 16 * 64 + 4 * 64))
#define MLS_BETA(bt, off_) do { _Pragma("unroll") for (int g = 0; g < 4; ++g) { const f32x4 x_ = *(const LAS f32x4*)(sc + SC_BE + (off_) + 8 * g + 4 * hi); \
            bt[4 * g] = x_.x; bt[4 * g + 1] = x_.y; bt[4 * g + 2] = x_.z; bt[4 * g + 3] = x_.w; } } while (0)
#define MLS_EMIT(aq, ap, it_) do { _Pragma("unroll") for (int g = 0; g < 4; ++g) { const f32x4 wa_ = *(const LAS f32x4*)(sc + SC_WI + 32 * (it_) + 8 * g + 4 * hi); \
                aq[4 * g] = aq[4 * g] * wa_.x + ap[4 * g]; aq[4 * g + 1] = aq[4 * g + 1] * wa_.y + ap[4 * g + 1]; aq[4 * g + 2] = aq[4 * g + 2] * wa_.z + ap[4 * g + 2]; aq[4 * g + 3] = aq[4 * g + 3] * wa_.w + ap[4 * g + 3]; } \
            _Pragma("unroll") for (int q = 0; q < 2; ++q) { \
                const u32x4 w0_ = {cvtpk_s(aq[8 * q], aq[8 * q + 1]), cvtpk_s(aq[8 * q + 2], aq[8 * q + 3]), cvtpk_s(aq[8 * q + 4], aq[8 * q + 5]), cvtpk_s(aq[8 * q + 6], aq[8 * q + 7])}; \
                *(LAS u32x4*)(PART + (((wid * 2 + (it_)) * 2 + q) * 64 + lane) * 16) = w0_; } } while (0)
            bf16x8 cb[2];
#pragma unroll
            for (int s = 0; s < 2; ++s) { const u32x4 w_ = {cvtpk_s(Cst[8 * s], Cst[8 * s + 1]), cvtpk_s(Cst[8 * s + 2], Cst[8 * s + 3]), cvtpk_s(Cst[8 * s + 4], Cst[8 * s + 5]), cvtpk_s(Cst[8 * s + 6], Cst[8 * s + 7])};
                cb[s] = __builtin_bit_cast(bf16x8, w_); }
            bf16x8 kf0, kf1, qf0, qf1, v0, v1, pa, pb;
            MLS_FRAG(kf0, KT, 0, 0); MLS_FRAG(kf1, KT, 0, 1);
            float rs0 = 0.f, rs1 = 0.f;
            {
                MLS_FRAG(qf0, QT, 0, 0); MLS_FRAG(qf1, QT, 0, 1);
                f32x16 aq = {}, ap = {}, st = {};
                aq = __builtin_amdgcn_mfma_f32_32x32x16_bf16(qf0, cb[0], aq, 0, 0, 0); aq = __builtin_amdgcn_mfma_f32_32x32x16_bf16(qf1, cb[1], aq, 0, 0, 0);
                st = __builtin_amdgcn_mfma_f32_32x32x16_bf16(kf0, qf0, st, 0, 0, 0); st = __builtin_amdgcn_mfma_f32_32x32x16_bf16(kf1, qf1, st, 0, 0, 0);
                const float al = sc[SC_AL + r32]; float bt[16]; MLS_BETA(bt, 0);
                MLS_VF(v0, VT, 0); MLS_VF(v1, VT, 1);
#pragma unroll
                for (int r = 0; r < 16; ++r) { float d = __builtin_amdgcn_exp2f(al + bt[r]); d = (crow(r, hi) <= r32) ? d : 0.f; st[r] *= d; rs0 += st[r]; }
                MLS_PK4(st, 0, pa); MLS_PK4(st, 8, pb);
                ap = __builtin_amdgcn_mfma_f32_32x32x16_bf16(pa, v0, ap, 0, 0, 0); ap = __builtin_amdgcn_mfma_f32_32x32x16_bf16(pb, v1, ap, 0, 0, 0);
                MLS_EMIT(aq, ap, 0);
            }
            MLS_SB();
            {
                MLS_FRAG(qf0, QT, 1, 0); MLS_FRAG(qf1, QT, 1, 1);
                f32x16 aq = {}, ap = {}, st = {};
                aq = __builtin_amdgcn_mfma_f32_32x32x16_bf16(qf0, cb[0], aq, 0, 0, 0); aq = __builtin_amdgcn_mfma_f32_32x32x16_bf16(qf1, cb[1], aq, 0, 0, 0);
                st = __builtin_amdgcn_mfma_f32_32x32x16_bf16(kf0, qf0, st, 0, 0, 0); st = __builtin_amdgcn_mfma_f32_32x32x16_bf16(kf1, qf1, st, 0, 0, 0);
                const float al = sc[SC_AL + 32 + r32];
                { float bt[16]; MLS_BETA(bt, 0);
                  MLS_VF(v0, VT, 0); MLS_VF(v1, VT, 1);
#pragma unroll
                  for (int r = 0; r < 16; ++r) { const float d = __builtin_amdgcn_exp2f(al + bt[r]); st[r] *= d; rs1 += st[r]; } }
                MLS_PK4(st, 0, pa); MLS_PK4(st, 8, pb);
                ap = __builtin_amdgcn_mfma_f32_32x32x16_bf16(pa, v0, ap, 0, 0, 0); ap = __builtin_amdgcn_mfma_f32_32x32x16_bf16(pb, v1, ap, 0, 0, 0);
                MLS_SB();
                MLS_FRAG(kf0, KT, 1, 0); MLS_FRAG(kf1, KT, 1, 1);
                st = (f32x16){};
                st = __builtin_amdgcn_mfma_f32_32x32x16_bf16(kf0, qf0, st, 0, 0, 0); st = __builtin_amdgcn_mfma_f32_32x32x16_bf16(kf1, qf1, st, 0, 0, 0);
                { float bt[16]; MLS_BETA(bt, 32);
                  MLS_VF(v0, VT, 2); MLS_VF(v1, VT, 3);
#pragma unroll
                  for (int r = 0; r < 16; ++r) { float d = __builtin_amdgcn_exp2f(al + bt[r]); d = (crow(r, hi) <= r32) ? d : 0.f; st[r] *= d; rs1 += st[r]; } }
                MLS_PK4(st, 0, pa); MLS_PK4(st, 8, pb);
                ap = __builtin_amdgcn_mfma_f32_32x32x16_bf16(pa, v0, ap, 0, 0, 0); ap = __builtin_amdgcn_mfma_f32_32x32x16_bf16(pb, v1, ap, 0, 0, 0);
                MLS_EMIT(aq, ap, 1);
            }
            MLS_SB();
            { auto rr = __builtin_amdgcn_permlane32_swap(__float_as_uint(rs0), __float_as_uint(rs0), false, false); rs0 = __uint_as_float(rr[0]) + __uint_as_float(rr[1]); }
            { auto rr = __builtin_amdgcn_permlane32_swap(__float_as_uint(rs1), __float_as_uint(rs1), false, false); rs1 = __uint_as_float(rr[0]) + __uint_as_float(rr[1]); }
            if (hi == 0) { RSP[wid * 64 + r32] = rs0; RSP[wid * 64 + 32 + r32] = rs1; }
            { const int i_ = tid >> 3, part = tid & 7; float acc = 0.f;
#pragma unroll
              for (int u = 0; u < 8; ++u) { const u32x2 qw = *(const LAS u32x2*)(QT + i_ * QP + (32 * part + 4 * u) * 2); const f32x4 nv = *(const LAS f32x4*)(NL + 32 * part + 4 * u);
                  acc += lo16(qw.x) * nv.x + hi16(qw.x) * nv.y + lo16(qw.y) * nv.z + hi16(qw.y) * nv.w; }
              acc += swz_xor<1>(acc); acc += swz_xor<2>(acc); acc += swz_xor<4>(acc);
              if (part == 0) QN[i_] = acc; }
        }
        __syncthreads();
        {
            if (c + 1 < SEQ / 64) LOAD_TILES(c + 1);
            const float decay = sc[SC_DEC];
#pragma unroll
            for (int r = 0; r < 16; ++r) Cst[r] *= decay;
#pragma unroll
            for (int K = 0; K < 4; ++K) {
                const bf16x8 af = cat8(trrd(KT + koff + K * 16 * QP), trrd(KT + koff + K * 16 * QP + 4 * QP));
                const bf16x8 bfr = cat8(trrd(WVT + voff + K * 16 * 64), trrd(WVT + voff + K * 16 * 64 + 4 * 64));
                Cst = __builtin_amdgcn_mfma_f32_32x32x16_bf16(af, bfr, Cst, 0, 0, 0);
            }
            { const int dp = tid & 127, jq = tid >> 7; float a0 = 0.f, a1 = 0.f;
#pragma unroll
              for (int jj = 0; jj < 16; ++jj) { const int j = 16 * jq + jj; const unsigned kw = *(const LAS unsigned*)(KT + j * QP + dp * 4); const float wj = sc[SC_W + j];
                  a0 += wj * lo16(kw); a1 += wj * hi16(kw); }
              *(LAS f32x2*)(NP + jq * 256 + 2 * dp) = (f32x2){a0, a1}; }
            if (wid < 4) {
                const int it = wid >> 1, q = wid & 1;
                float num[8];
#pragma unroll
                for (int k = 0; k < 8; ++k) num[k] = 0.f;
#pragma unroll
                for (int w8 = 0; w8 < 8; ++w8) { const u32x4 pv = *(const LAS u32x4*)(PART + (((w8 * 2 + it) * 2 + q) * 64 + lane) * 16);
                    num[0] += lo16(pv.x); num[1] += hi16(pv.x); num[2] += lo16(pv.y); num[3] += hi16(pv.y); num[4] += lo16(pv.z); num[5] += hi16(pv.z); num[6] += lo16(pv.w); num[7] += hi16(pv.w); }
                const int ia = 32 * it + 16 * q + 4 * hi, ib = ia + 8;
                f32x4 ra = {0.f, 0.f, 0.f, 0.f}, rb = {0.f, 0.f, 0.f, 0.f};
#pragma unroll
                for (int w8 = 0; w8 < 8; ++w8) { ra += *(const LAS f32x4*)(RSP + w8 * 64 + ia); rb += *(const LAS f32x4*)(RSP + w8 * 64 + ib); }
                const f32x4 qa = *(const LAS f32x4*)(QN + ia), qb = *(const LAS f32x4*)(QN + ib);
                const f32x4 wia = *(const LAS f32x4*)(sc + SC_WI + ia), wib = *(const LAS f32x4*)(sc + SC_WI + ib);
                const f32x4 ema = *(const LAS f32x4*)(sc + SC_EM + ia), emb = *(const LAS f32x4*)(sc + SC_EM + ib);
                float hv[8];
#pragma unroll
                for (int k = 0; k < 4; ++k) { const float da = wia[k] * qa[k] + ra[k], db = wib[k] * qb[k] + rb[k];
                    hv[k] = num[k] / fmaxf(fabsf(da), ema[k]); hv[4 + k] = num[4 + k] / fmaxf(fabsf(db), emb[k]); }
#pragma unroll
                for (int k = 0; k < 8; ++k) {
                    const int irow = (k < 4 ? ia + k : ib + k - 4); const size_t tok = (size_t)c * 64 + irow;
                    float s1 = hv[k], s2 = hv[k] * hv[k];
                    s1 += swz_xor<1>(s1); s2 += swz_xor<1>(s2); s1 += swz_xor<2>(s1); s2 += swz_xor<2>(s2); s1 += swz_xor<4>(s1); s2 += swz_xor<4>(s2);
                    s1 += swz_xor<8>(s1); s2 += swz_xor<8>(s2); s1 += swz_xor<16>(s1); s2 += swz_xor<16>(s2);
                    if (r32 == 0) { float* st = STt + tok * 64; st[0] = s1; st[1] = s2; }
                    const float vn = swz_xor<1>(hv[k]);
                    if ((r32 & 1) == 0) *(unsigned*)(XMh + tok * NPROJ + r32) = cvtpk_s(hv[k], vn);
                }
            }
            if (c + 1 < SEQ / 64) SCALARS((c + 1) & 1);
        }
        __syncthreads();
        if (tid < 256) { nreg = sc[SC_DEC] * nreg + ((NP[tid] + NP[256 + tid]) + (NP[512 + tid] + NP[768 + tid])); NL[tid] = nreg; }
        if (c + 1 < SEQ / 64) { TILE_WRITE(); V_WRITE((c + 1) & 1); }
        __syncthreads();
    }
#undef LOAD_GATES
#undef LOAD_TILES
#undef TILE_WRITE
#undef V_WRITE
#undef SCALARS
#undef MLS_SB
#undef MLS_FRAG
#undef MLS_VF
#undef MLS_BETA
#undef MLS_EMIT
}
#undef MLS_PK4
}

typedef unsigned u32x2 __attribute__((ext_vector_type(2)));
struct Ctx {
    LAS unsigned char* lds;
    int tid, lane, wave, vcu, G;
    const float* in[18];
    float* out; unsigned char* ws;
};
__device__ __forceinline__ float bf_lo(unsigned w) { return __uint_as_float(w << 16); }
__device__ __forceinline__ float bf_hi(unsigned w) { return __uint_as_float(w & 0xffff0000u); }
__device__ __forceinline__ float wave_sum(float v) {
#pragma unroll
    for (int o = 1; o < 64; o <<= 1) v += __shfl_xor(v, o);
    return v;
}
__device__ __forceinline__ float log_sigmoidf(float x) { return fminf(x, 0.f) - log1pf(expf(-fabsf(x))); }
__device__ __forceinline__ float siluf(float x) { return x / (1.f + __expf(-x)); }

__device__ __forceinline__ void p0_transpose_item(const float* W, int K, int pitch, int nblk, bf16* WT, LAS float* scr, int item, int lane) {
    const int kb = item / nblk, nb = item % nblk, k0 = 64 * kb, n0 = 32 * nb;
#pragma unroll 8
    for (int i = 0; i < 32; ++i) { const int kk = 2 * i + (lane >> 5); scr[kk * 33 + (lane & 31)] = W[(size_t)(k0 + kk) * pitch + n0 + (lane & 31)]; }
    LDS_WAIT(); asm volatile("" ::: "memory");
    const int c = lane & 7;
#pragma unroll
    for (int j = 0; j < 4; ++j) { const int n = (lane >> 3) + 8 * j; const LAS float* s = scr + (8 * c) * 33 + n;
        v4u o; o.x = pk2(s[0 * 33], s[1 * 33]); o.y = pk2(s[2 * 33], s[3 * 33]); o.z = pk2(s[4 * 33], s[5 * 33]); o.w = pk2(s[6 * 33], s[7 * 33]);
        *(GAS v4u*)(WT + (size_t)(n0 + n) * K + k0 + 8 * c) = o; }
    LDS_WAIT(); asm volatile("" ::: "memory");
}
__device__ __forceinline__ void p0_row(const Ctx& C, int m) {
    const float* x = C.in[0]; const float* ng = C.in[1]; const float* w_in = C.in[2]; const float* fbias = C.in[14];
    bf16* HN = (bf16*)(C.ws + WS_HN); float* LFF = (float*)(C.ws + WS_LFF);
    const int lane = C.lane;
    const f32x4* xr = (const f32x4*)(x + (size_t)m * DM) + lane;
    f32x4 v[4]; float s = 0.f;
#pragma unroll
    for (int j = 0; j < 4; ++j) { v[j] = xr[64 * j]; s += (v[j].x * v[j].x + v[j].y * v[j].y) + (v[j].z * v[j].z + v[j].w * v[j].w); }
    const float r = 1.0f / sqrtf(wave_sum(s) * (1.f / DM) + EPS);
    const f32x4* gr = (const f32x4*)ng + lane;
    float acc[8];
#pragma unroll
    for (int q = 0; q < 8; ++q) acc[q] = 0.f;
    unsigned long long* o8 = (unsigned long long*)(HN + (size_t)m * DM) + lane;
#pragma unroll
    for (int j = 0; j < 4; ++j) {
        const f32x4 g = gr[64 * j]; f32x4 h = (v[j] * r) * g;
        o8[64 * j] = (unsigned long long)pk2(h.x, h.y) | ((unsigned long long)pk2(h.z, h.w) << 32);
#pragma unroll
        for (int e = 0; e < 4; ++e) { const int k = 256 * j + 4 * lane + e; const float* wr = w_in + (size_t)k * NPROJ_FULL + NPROJ;
            const f32x4 wa = *(const f32x4*)wr, wb = *(const f32x4*)(wr + 4); const float he = h[e];
            acc[0] += he * wa.x; acc[1] += he * wa.y; acc[2] += he * wa.z; acc[3] += he * wa.w;
            acc[4] += he * wb.x; acc[5] += he * wb.y; acc[6] += he * wb.z; acc[7] += he * wb.w; }
    }
    float mine = 0.f;
#pragma unroll
    for (int q = 0; q < 8; ++q) { const float t = wave_sum(acc[q]); if (lane == q) mine = t; }
    if (lane < 8) LFF[(size_t)m * 8 + lane] = log_sigmoidf(mine + fbias[lane]);
}
__device__ __forceinline__ void p0_prologue(const Ctx& C) {
    LAS float* scr = (LAS float*)(C.lds + RING_OFF + C.wave * 16384);
    const int gw = C.vcu * NWAVES + C.wave, NGW = C.G * NWAVES;
    constexpr int I_IN = (DM / 64) * (NPROJ / 32), I_OUT = (DMIX / 64) * (DM / 32);
    bf16* WIN_T = (bf16*)(C.ws + WS_WIN); bf16* WOUT_T = (bf16*)(C.ws + WS_WOUT);
    for (int it = gw; it < I_IN + I_OUT; it += NGW) {
        if (it < I_IN) p0_transpose_item(C.in[2], DM, NPROJ_FULL, NPROJ / 32, WIN_T, scr, it, C.lane);
        else p0_transpose_item(C.in[16], DMIX, DM, DM / 32, WOUT_T, scr, it - I_IN, C.lane);
    }
    for (int m = gw; m < T; m += NGW) p0_row(C, m);
    {
        const float* wq = C.in[5]; const float* wk = C.in[6]; const float* wv = C.in[7]; const float* wi = C.in[8]; const float* wf = C.in[10];
        float* WGE = (float*)(C.ws + WS_WGE);
        for (int gt = C.vcu * 512 + C.tid; gt < 2048 * 8; gt += C.G * 512) {
            const int c = gt >> 3, gate = gt & 7, gh = gate & 3; const float* Wg = gate < 4 ? wi : wf;
            float s = 0.f;
            if (c < 1024) { const int n = c >> 2, i = c & 3;
#pragma unroll
                for (int o = 0; o < 4; ++o) s += wq[n * 16 + i * 4 + o] * Wg[(4 * n + o) * 4 + gh] + (wk[n * 16 + i * 4 + o] * 0.0625f) * Wg[(1024 + 4 * n + o) * 4 + gh];
            } else { const int cc = c - 1024, n = cc >> 2, i = cc & 3;
#pragma unroll
                for (int o = 0; o < 4; ++o) s += wv[n * 16 + i * 4 + o] * Wg[(2048 + 4 * n + o) * 4 + gh]; }
            WGE[gt] = s;
        }
    }
}

__device__ __forceinline__ void p2_prepass(const Ctx& C) {
    const int tid = C.tid, lane = C.lane, wave = C.wave;
    const bf16* PROJ = (const bf16*)(C.ws + WS_PROJ); bf16* XC = (bf16*)(C.ws + WS_HN);
    bf16* QM = (bf16*)C.out; bf16* KM = QM + (size_t)T * DM;
    float* GATES = (float*)(C.ws + WS_GATES); const float* WGE = (const float*)(C.ws + WS_WGE);
    LAS float* red = (LAS float*)(C.lds + RING_OFF);
    const int g = tid & 255, half = tid >> 8;
    float cw[4][4], cb[4], wq[16], wk[16], gec[4][8], gem[4][8];
#pragma unroll
    for (int tap = 0; tap < 4; ++tap) { const f32x4 w = *(const f32x4*)(C.in[3] + tap * DM + 4 * g); cw[tap][0] = w.x; cw[tap][1] = w.y; cw[tap][2] = w.z; cw[tap][3] = w.w; }
    { const f32x4 b = *(const f32x4*)(C.in[4] + 4 * g); cb[0] = b.x; cb[1] = b.y; cb[2] = b.z; cb[3] = b.w; }
#pragma unroll
    for (int i = 0; i < 4; ++i) { const f32x4 a = *(const f32x4*)(C.in[5] + g * 16 + 4 * i), b = *(const f32x4*)(C.in[6] + g * 16 + 4 * i);
        wq[4 * i] = a.x; wq[4 * i + 1] = a.y; wq[4 * i + 2] = a.z; wq[4 * i + 3] = a.w;
        wk[4 * i] = b.x * 0.0625f; wk[4 * i + 1] = b.y * 0.0625f; wk[4 * i + 2] = b.z * 0.0625f; wk[4 * i + 3] = b.w * 0.0625f; }
#pragma unroll
    for (int ch = 0; ch < 4; ++ch) {
        const f32x4 a0 = *(const f32x4*)(WGE + (size_t)(4 * g + ch) * 8), a1 = *(const f32x4*)(WGE + (size_t)(4 * g + ch) * 8 + 4);
        const f32x4 b0 = *(const f32x4*)(WGE + (size_t)(1024 + 4 * g + ch) * 8), b1 = *(const f32x4*)(WGE + (size_t)(1024 + 4 * g + ch) * 8 + 4);
        gec[ch][0] = a0.x; gec[ch][1] = a0.y; gec[ch][2] = a0.z; gec[ch][3] = a0.w; gec[ch][4] = a1.x; gec[ch][5] = a1.y; gec[ch][6] = a1.z; gec[ch][7] = a1.w;
        gem[ch][0] = b0.x; gem[ch][1] = b0.y; gem[ch][2] = b0.z; gem[ch][3] = b0.w; gem[ch][4] = b1.x; gem[ch][5] = b1.y; gem[ch][6] = b1.z; gem[ch][7] = b1.w;
    }
    for (int tile = blockIdx.x; tile < T / 64; tile += C.G) {
        const int t0 = tile * 64 + half * 32, s0 = t0 & (SEQ - 1);
        float x1[4], x2[4], x3[4];
#pragma unroll
        for (int ch = 0; ch < 4; ++ch) { x1[ch] = 0.f; x2[ch] = 0.f; x3[ch] = 0.f; }
        if (s0 >= 3) {
            const u32x2 r1 = *(const u32x2*)(PROJ + (size_t)(t0 - 1) * NPROJ + 4 * g), r2 = *(const u32x2*)(PROJ + (size_t)(t0 - 2) * NPROJ + 4 * g), r3 = *(const u32x2*)(PROJ + (size_t)(t0 - 3) * NPROJ + 4 * g);
            x1[0] = bf_lo(r1.x); x1[1] = bf_hi(r1.x); x1[2] = bf_lo(r1.y); x1[3] = bf_hi(r1.y);
            x2[0] = bf_lo(r2.x); x2[1] = bf_hi(r2.x); x2[2] = bf_lo(r2.y); x2[3] = bf_hi(r2.y);
            x3[0] = bf_lo(r3.x); x3[1] = bf_hi(r3.x); x3[2] = bf_lo(r3.y); x3[3] = bf_hi(r3.y);
        }
#pragma unroll 2
        for (int i = 0; i < 32; ++i) {
            const size_t t = (size_t)t0 + i;
            const u32x2 raw = *(const u32x2*)(PROJ + t * NPROJ + 4 * g);
            float x[4] = {bf_lo(raw.x), bf_hi(raw.x), bf_lo(raw.y), bf_hi(raw.y)};
            float xc[4];
#pragma unroll
            for (int ch = 0; ch < 4; ++ch) { float y = cb[ch]; y += x3[ch] * cw[0][ch]; y += x2[ch] * cw[1][ch]; y += x1[ch] * cw[2][ch]; y += x[ch] * cw[3][ch]; xc[ch] = siluf(y); }
            float q[4], k[4];
#pragma unroll
            for (int o = 0; o < 4; ++o) { q[o] = xc[0] * wq[o] + xc[1] * wq[4 + o] + xc[2] * wq[8 + o] + xc[3] * wq[12 + o];
                                          k[o] = xc[0] * wk[o] + xc[1] * wk[4 + o] + xc[2] * wk[8 + o] + xc[3] * wk[12 + o]; }
            float gp[8];
#pragma unroll
            for (int gt = 0; gt < 8; ++gt) { float a = 0.f;
#pragma unroll
                for (int ch = 0; ch < 4; ++ch) a += xc[ch] * gec[ch][gt] + x[ch] * gem[ch][gt];
                gp[gt] = a; }
            { u32x2 w; w.x = pk2(xc[0], xc[1]); w.y = pk2(xc[2], xc[3]); *(u32x2*)(XC + t * DM + 4 * g) = w; }
            { u32x2 w; w.x = pk2(q[0], q[1]); w.y = pk2(q[2], q[3]); *(u32x2*)(QM + t * DM + 4 * g) = w; }
            { u32x2 w; w.x = pk2(k[0], k[1]); w.y = pk2(k[2], k[3]); *(u32x2*)(KM + t * DM + 4 * g) = w; }
            float r4[4], r2[2], r1;
            const bool b5 = lane & 32, b4 = lane & 16, b3 = lane & 8;
#pragma unroll
            for (int kk = 0; kk < 4; ++kk) { const float snd = b5 ? gp[kk] : gp[kk + 4]; const float rcv = __shfl_xor(snd, 32); r4[kk] = (b5 ? gp[kk + 4] : gp[kk]) + rcv; }
#pragma unroll
            for (int kk = 0; kk < 2; ++kk) { const float snd = b4 ? r4[kk] : r4[kk + 2]; const float rcv = __shfl_xor(snd, 16); r2[kk] = (b4 ? r4[kk + 2] : r4[kk]) + rcv; }
            { const float snd = b3 ? r2[0] : r2[1]; const float rcv = __shfl_xor(snd, 8); r1 = (b3 ? r2[1] : r2[0]) + rcv; }
            r1 += __shfl_xor(r1, 4); r1 += __shfl_xor(r1, 2); r1 += __shfl_xor(r1, 1);
            if ((lane & 7) == 0) { const int gate = (b5 ? 4 : 0) + (b4 ? 2 : 0) + (b3 ? 1 : 0); red[((half * 32 + i) * 4 + (wave & 3)) * 8 + gate] = r1; }
#pragma unroll
            for (int ch = 0; ch < 4; ++ch) { x3[ch] = x2[ch]; x2[ch] = x1[ch]; x1[ch] = x[ch]; }
        }
        __syncthreads();
        { const int tok = tid >> 3, gate = tid & 7;
          float val = red[(tok * 4 + 0) * 8 + gate] + red[(tok * 4 + 1) * 8 + gate] + red[(tok * 4 + 2) * 8 + gate] + red[(tok * 4 + 3) * 8 + gate];
          val += gate < 4 ? C.in[9][gate] : C.in[11][gate - 4];
          GATES[(size_t)(tile * 64 + tok) * 8 + gate] = gate < 4 ? val : log_sigmoidf(val); }
        __syncthreads();
    }
    {
        const float* LFF = (const float*)(C.ws + WS_LFF); float* UTAB = (float*)(C.ws + WS_UTAB);
        LAS float* wsum = (LAS float*)(C.lds + RING_OFF + 16384);
        for (int bh = blockIdx.x; bh < BATCH * 8; bh += C.G) {
            const int b = bh >> 3, h = bh & 7, s = 4 * tid;
            float p[4];
#pragma unroll
            for (int j = 0; j < 4; ++j) p[j] = LFF[((size_t)b * SEQ + s + j) * 8 + h];
            p[1] += p[0]; p[2] += p[1]; p[3] += p[2];
            float incl = p[3];
#pragma unroll
            for (int o = 1; o < 64; o <<= 1) { const float tv = __shfl_up(incl, o); if (lane >= o) incl += tv; }
            if (lane == 63) wsum[wave] = incl;
            __syncthreads();
            float base = incl - p[3];
            for (int w = 0; w < wave; ++w) base += wsum[w];
#pragma unroll
            for (int j = 0; j < 4; ++j) UTAB[(size_t)bh * SEQ + s + j] = -(base + p[j]) * FOX_ISCALE;
            __syncthreads();
        }
    }
}

__device__ __forceinline__ void p3_naive_fox(const Ctx& C) {
    const int gw = C.vcu * NWAVES + C.wave, NGW = C.G * NWAVES, lane = C.lane;
    bf16* PROJ = (bf16*)(C.ws + WS_PROJ); const float* UTAB = (const float*)(C.ws + WS_UTAB); const float* gain = C.in[15];
    for (int idx = gw; idx < BATCH * 8 * SEQ; idx += NGW) {
        const int bh = idx >> 11, s = ((idx & 2047) + 331 * bh) & 2047, b = bh >> 3, h = bh & 7;
        const size_t t = (size_t)b * SEQ + s; const int col = h * 128 + 2 * lane;
        const unsigned qraw = *(const unsigned*)(PROJ + t * NPROJ + COL_QF + col);
        const float q0 = bf_lo(qraw), q1 = bf_hi(qraw);
        const float* ut = UTAB + (size_t)bh * SEQ; const float us = ut[s];
        float M = -INFINITY, l = 0.f, a0 = 0.f, a1 = 0.f;
        for (int ss = 0; ss <= s; ++ss) {
            const size_t tt = (size_t)b * SEQ + ss;
            const unsigned kraw = *(const unsigned*)(PROJ + tt * NPROJ + COL_KF + col);
            const unsigned vraw = *(const unsigned*)(PROJ + tt * NPROJ + COL_VF + col);
            float d = q0 * bf_lo(kraw) + q1 * bf_hi(kraw); d = wave_sum(d);
            const float xl = (d + (ut[ss] - us)) * FOX_SCALE;
            if (xl > M) { const float sc = __expf(M - xl); l *= sc; a0 *= sc; a1 *= sc; M = xl; }
            const float p = __expf(xl - M); l += p; a0 += p * bf_lo(vraw); a1 += p * bf_hi(vraw);
        }
        const float o0 = a0 / l, o1 = a1 / l;
        const float r = 1.0f / sqrtf(wave_sum(o0 * o0 + o1 * o1) * (1.f / 128.f) + EPS);
        const unsigned zraw = *(const unsigned*)(PROJ + t * NPROJ + COL_ZF + col);
        const float y0 = (o0 * r) * gain[col] * siluf(bf_lo(zraw)), y1 = (o1 * r) * gain[col + 1] * siluf(bf_hi(zraw));
        *(unsigned*)(PROJ + t * NPROJ + COL_QF + col) = pk2(y0, y1);
    }
}
__device__ __forceinline__ void p4_naive_mlstm(const Ctx& C, int hm_col) {
    const int gw = C.vcu * NWAVES + C.wave, NGW = C.G * NWAVES, lane = C.lane;
    bf16* PROJ = (bf16*)(C.ws + WS_PROJ); const bf16* QM = (const bf16*)C.out; const bf16* KM = QM + (size_t)T * DM;
    const float* GATES = (const float*)(C.ws + WS_GATES); float* STATS = (float*)(C.ws + WS_STATS);
    for (int idx = gw; idx < BATCH * 4 * SEQ; idx += NGW) {
        const int bh = idx >> 11, s = ((idx & 2047) + 331 * bh) & 2047, b = bh >> 2, h = bh & 3;
        const size_t t = (size_t)b * SEQ + s; const int col = h * 256 + 4 * lane;
        float wv[16];
#pragma unroll
        for (int i = 0; i < 4; ++i) { const f32x4 a = *(const f32x4*)(C.in[7] + (size_t)(h * 64 + lane) * 16 + 4 * i); wv[4 * i] = a.x; wv[4 * i + 1] = a.y; wv[4 * i + 2] = a.z; wv[4 * i + 3] = a.w; }
        const u32x2 qr = *(const u32x2*)(QM + t * DM + col);
        const float q0 = bf_lo(qr.x), q1 = bf_hi(qr.x), q2 = bf_lo(qr.y), q3 = bf_hi(qr.y);
        float D = 0.f, M = -INFINITY, den = 0.f, a0 = 0.f, a1 = 0.f, a2 = 0.f, a3 = 0.f;
        for (int ss = s; ss >= 0; --ss) {
            const size_t tt = (size_t)b * SEQ + ss;
            const u32x2 kr = *(const u32x2*)(KM + tt * DM + col);
            const u32x2 xr = *(const u32x2*)(PROJ + tt * NPROJ + COL_XM + col);
            float d = q0 * bf_lo(kr.x) + q1 * bf_hi(kr.x) + q2 * bf_lo(kr.y) + q3 * bf_hi(kr.y); d = wave_sum(d);
            const float lw = D + GATES[tt * 8 + h];
            const float x0 = bf_lo(xr.x), x1 = bf_hi(xr.x), x2 = bf_lo(xr.y), x3 = bf_hi(xr.y);
            const float v0 = x0 * wv[0] + x1 * wv[4] + x2 * wv[8] + x3 * wv[12], v1 = x0 * wv[1] + x1 * wv[5] + x2 * wv[9] + x3 * wv[13];
            const float v2 = x0 * wv[2] + x1 * wv[6] + x2 * wv[10] + x3 * wv[14], v3 = x0 * wv[3] + x1 * wv[7] + x2 * wv[11] + x3 * wv[15];
            if (lw > M) { const float sc = __expf(M - lw); den *= sc; a0 *= sc; a1 *= sc; a2 *= sc; a3 *= sc; M = lw; }
            const float wd = __expf(lw - M) * d;
            den += wd; a0 += wd * v0; a1 += wd * v1; a2 += wd * v2; a3 += wd * v3;
            D += GATES[tt * 8 + 4 + h];
        }
        const float inv = 1.0f / fmaxf(fabsf(den), __expf(-M));
        const float h0 = a0 * inv, h1 = a1 * inv, h2 = a2 * inv, h3 = a3 * inv;
        float s1 = (h0 + h1) + (h2 + h3), s2 = (h0 * h0 + h1 * h1) + (h2 * h2 + h3 * h3);
        s1 += __shfl_xor(s1, 1); s2 += __shfl_xor(s2, 1); s1 += __shfl_xor(s1, 2); s2 += __shfl_xor(s2, 2); s1 += __shfl_xor(s1, 4); s2 += __shfl_xor(s2, 4);
        if ((lane & 7) == 0) { float* st = STATS + ((t * 4 + h) * 8 + (lane >> 3)) * 2; st[0] = s1; st[1] = s2; }
        u32x2 w; w.x = pk2(h0, h1); w.y = pk2(h2, h3);
        *(u32x2*)(PROJ + t * NPROJ + hm_col + col) = w;
    }
}
__device__ __forceinline__ void p5_ym(const Ctx& C, int hm_col) {
    bf16* PROJ = (bf16*)(C.ws + WS_PROJ); const bf16* XC = (const bf16*)(C.ws + WS_HN); const float* STATS = (const float*)(C.ws + WS_STATS);
    const float* gain = C.in[12]; const float* skip = C.in[13];
    for (int tile = blockIdx.x; tile < T / 64; tile += C.G) {
#pragma unroll 2
        for (int it = 0; it < 16; ++it) {
            const int id = it * 512 + C.tid, tok = id >> 7, c0 = (id & 127) * 8, head = c0 >> 8; const size_t t = (size_t)tile * 64 + tok;
            const f32x4* st = (const f32x4*)(STATS + (t * 4 + head) * 16);
            const f32x4 sa = st[0], sb = st[1], sc = st[2], sd = st[3];
            const float sum = (sa.x + sa.z) + (sb.x + sb.z) + (sc.x + sc.z) + (sd.x + sd.z), sq = (sa.y + sa.w) + (sb.y + sb.w) + (sc.y + sc.w) + (sd.y + sd.w);
            const float mu = sum * (1.f / 256.f), var = fmaxf(sq * (1.f / 256.f) - mu * mu, 0.f), rstd = 1.0f / sqrtf(var + EPS);
            const v4u hr = *(const v4u*)(PROJ + t * NPROJ + hm_col + c0), xr = *(const v4u*)(XC + t * DM + c0), zr = *(const v4u*)(PROJ + t * NPROJ + COL_ZM + c0);
            const f32x4 g0 = *(const f32x4*)(gain + c0), g1 = *(const f32x4*)(gain + c0 + 4), k0 = *(const f32x4*)(skip + c0), k1 = *(const f32x4*)(skip + c0 + 4);
            const unsigned hw[4] = {hr.x, hr.y, hr.z, hr.w}, xw[4] = {xr.x, xr.y, xr.z, xr.w}, zw[4] = {zr.x, zr.y, zr.z, zr.w};
            const float gg[8] = {g0.x, g0.y, g0.z, g0.w, g1.x, g1.y, g1.z, g1.w}, kk[8] = {k0.x, k0.y, k0.z, k0.w, k1.x, k1.y, k1.z, k1.w};
            unsigned ow[4];
#pragma unroll
            for (int j = 0; j < 4; ++j) {
                const float ya = ((bf_lo(hw[j]) - mu) * rstd * gg[2 * j] + kk[2 * j] * bf_lo(xw[j])) * siluf(bf_lo(zw[j]));
                const float yb = ((bf_hi(hw[j]) - mu) * rstd * gg[2 * j + 1] + kk[2 * j + 1] * bf_hi(xw[j])) * siluf(bf_hi(zw[j]));
                ow[j] = pk2(ya, yb);
            }
            *(v4u*)(PROJ + t * NPROJ + COL_ZM + c0) = (v4u){ow[0], ow[1], ow[2], ow[3]};
        }
    }
}
__device__ __forceinline__ void p7_final_norm(const Ctx& C) {
    const int gw = C.vcu * NWAVES + C.wave, NGW = C.G * NWAVES, lane = C.lane; const float* fg = C.in[17];
    for (int m = gw; m < T; m += NGW) {
        f32x4* xr = (f32x4*)(C.out + (size_t)m * DM) + lane; f32x4 v[4]; float s = 0.f;
#pragma unroll
        for (int j = 0; j < 4; ++j) { v[j] = xr[64 * j]; s += (v[j].x * v[j].x + v[j].y * v[j].y) + (v[j].z * v[j].z + v[j].w * v[j].w); }
        const float r = 1.0f / sqrtf(wave_sum(s) * (1.f / DM) + EPS);
        const f32x4* gr = (const f32x4*)fg + lane;
#pragma unroll
        for (int j = 0; j < 4; ++j) xr[64 * j] = (v[j] * r) * gr[64 * j];
    }
}

#ifndef NAIVE_FOX
#define NAIVE_FOX 0
#endif
#ifndef NAIVE_MLSTM
#define NAIVE_MLSTM 0
#endif
struct Args { const float* in[18]; float* out; unsigned char* ws; int ph_lo, ph_hi; };
__global__ void __launch_bounds__(NWAVES * 64, 2) hy_fwd(Args args) {
    extern __shared__ __attribute__((aligned(16))) unsigned char lds[];
    Ctx C;
    C.lds = (LAS unsigned char*)lds;
    C.tid = threadIdx.x; C.lane = C.tid & 63; C.wave = __builtin_amdgcn_readfirstlane(C.tid >> 6);
    C.G = gridDim.x; { const int bx = blockIdx.x; C.vcu = (C.G % 8 == 0) ? (bx % 8) * (C.G / 8) + bx / 8 : bx; }
#pragma unroll
    for (int i = 0; i < 18; ++i) C.in[i] = args.in[i];
    C.out = args.out; C.ws = args.ws;
    volatile LAS unsigned* MISC = (volatile LAS unsigned*)(C.lds + MISC_OFF);
    gu32* ctl = (gu32*)(args.ws + WS_CTL);
    for (int u = C.tid; u < (LDS_BYTES - LDSCTL_OFF) / 4; u += NWAVES * 64) ((LAS unsigned*)(C.lds + LDSCTL_OFF))[u] = 0u;
    __syncthreads();
    const int lo = args.ph_lo, hi = args.ph_hi;
    const bool multi = (hi - lo) > 1;
    XcdBarrier bar; bar.bar = (unsigned*)(ctl + CW_BAR); bar.x = 0; bar.st = nullptr;
    if (multi) bar = xcd_barrier_post((unsigned*)(ctl + CW_BAR), MISC + 8);
#define IN(k) (lo <= (k) && (k) < hi)
#define SEAM(k) do { if (IN(k) && IN((k) + 1)) xcd_barrier(bar); } while (0)

    if (IN(0)) { p0_prologue(C); SEAM(0); }
    if (IN(1)) {
        pg8::Gemm g{(const pg8::bf16_t*)(C.ws + WS_HN), (const pg8::bf16_t*)(C.ws + WS_WIN), T, NPROJ, DM, DM, DM};
        pg8::StaticOrder S; S.init(T, NPROJ, C.G, (int)blockIdx.x);
        pg8::EpiBf16<0> E{(pg8::bf16_t*)(C.ws + WS_PROJ), NPROJ, nullptr, 0, 0, 1.f};
        pg8::gemm_phase<pg8::EpiBf16<0>, pg8::StaticOrder, PG8_ALIGN, PG8_SP2>(C.lds + RING_OFF, g, S, E);
        SEAM(1);
    }
    if (IN(2)) { p2_prepass(C); SEAM(2); }
    if (IN(3)) {
#if NAIVE_MLSTM == 0
        for (int item = C.vcu; item < BATCH * 4 * 8; item += C.G) mls::mlstm_item(C.lds + RING_OFF, C.ws, (const mls::bf*)C.out, C.in[7], item);
#endif
#if NAIVE_FOX
        p3_naive_fox(C);
#else
        fox::fox_phase((char*)lds + RING_OFF, C.lds + RING_OFF, C.ws, C.in[15], C.G, C.vcu);
#endif
        SEAM(3); }
#if NAIVE_MLSTM
    if (IN(4)) { p4_naive_mlstm(C, COL_KF); SEAM(4); }
    if (IN(5)) { p5_ym(C, COL_KF); SEAM(5); }
#else
    if (IN(5)) { p5_ym(C, COL_XM); SEAM(5); }
#endif
    if (IN(6)) {
        pg8::Gemm g{(const pg8::bf16_t*)(C.ws + WS_PROJ) + COL_ZM, (const pg8::bf16_t*)(C.ws + WS_WOUT), T, DM, DMIX, NPROJ, DMIX};
        pg8::StaticOrder S; S.init(T, DM, C.G, (int)blockIdx.x);
        pg8::EpiResF32 E{C.in[0], C.out, DM};
        pg8::gemm_phase<pg8::EpiResF32, pg8::StaticOrder, false, PG8_SP2>(C.lds + RING_OFF, g, S, E);
        SEAM(6);
    }
    if (IN(7)) { p7_final_norm(C); }
#undef IN
#undef SEAM
}

extern "C" void kernel_launch(void* const* d_in, const int* in_sizes, int n_in, void* d_out, int out_size, void* d_ws, size_t ws_size, hipStream_t stream) {
    static int grid = 0;
    if (grid == 0) {
        if (n_in != 18 || in_sizes[0] != T * DM || out_size != T * DM || ws_size < WS_END) {
            fprintf(stderr, "kernel_launch: built for 18 inputs, x/out of %d floats, >= %zu bytes of workspace; got n_in %d, in0 %d, out %d, ws %zu; nothing launched\n", T * DM, (size_t)WS_END, n_in, n_in > 0 ? in_sizes[0] : -1, out_size, ws_size);
            grid = -1; return; }
        int dev = 0, cus = 0, per_cu = 0;
        if (hipGetDevice(&dev) != hipSuccess || hipDeviceGetAttribute(&cus, hipDeviceAttributeMultiprocessorCount, dev) != hipSuccess) { fprintf(stderr, "kernel_launch: device query failed\n"); grid = -1; return; }
        if (hipFuncSetAttribute((const void*)hy_fwd, hipFuncAttributeMaxDynamicSharedMemorySize, LDS_BYTES) != hipSuccess) { fprintf(stderr, "kernel_launch: hipFuncSetAttribute failed\n"); grid = -1; return; }
        if (hipOccupancyMaxActiveBlocksPerMultiprocessor(&per_cu, (const void*)hy_fwd, NWAVES * 64, LDS_BYTES) != hipSuccess || per_cu < 1)
            fprintf(stderr, "kernel_launch: note: occupancy query reports %d workgroups per CU\n", per_cu);
        (void)hipGetLastError();
        grid = cus;
    }
    if (grid < 0) return;
    if (hipMemsetAsync((char*)d_ws + WS_CTL, 0, CTL_ZERO_BYTES, stream) != hipSuccess) { fprintf(stderr, "kernel_launch: memset failed\n"); return; }
    Args a{};
    for (int i = 0; i < 18; ++i) a.in[i] = (const float*)d_in[i];
    a.out = (float*)d_out; a.ws = (unsigned char*)d_ws;
#if MK_N_LAUNCHES == 1
    a.ph_lo = 0; a.ph_hi = N_PHASES;
    hipLaunchKernelGGL(hy_fwd, dim3(grid), dim3(NWAVES * 64), LDS_BYTES, stream, a);
#else
    for (int p = 0; p < N_PHASES; ++p) { a.ph_lo = p; a.ph_hi = p + 1; hipLaunchKernelGGL(hy_fwd, dim3(grid), dim3(NWAVES * 64), LDS_BYTES, stream, a); }
#endif
    const hipError_t le = hipPeekAtLastError();
    if (le != hipSuccess) fprintf(stderr, "kernel_launch: launch failed: %s\n", hipGetErrorName(le));
}
```
